# Optimizing an MI355X kernel written in HIP

```python
import math
import jax, jax.numpy as jnp
from jax import lax
import numpy as np

D_MODEL = 1024
BATCH = 8
SEQ = 4096
DEPTH = 1

D_MIX = D_MODEL
A_HEAD_DIM = 64
A_HEADS = (D_MIX // 2) // A_HEAD_DIM
A_WIDTH = A_HEADS * A_HEAD_DIM
DILATED_PATTERNS = ((128, 1), (512, 4), (2048, 16))
BLOCK = 128
B_HEADS = 8
QK_NOPE_DIM = 64
QK_ROPE_DIM = 32
V_HEAD_DIM = (D_MIX - A_WIDTH) // B_HEADS
B_WIDTH = B_HEADS * V_HEAD_DIM
Q_LORA_RANK = 256
KV_LORA_RANK = 128
ROPE_THETA = 10000.0
REL_BUCKETS = 32
REL_MAX_DISTANCE = 2048
EPS = 1e-6

IN_SPLITS = (A_WIDTH, A_WIDTH, A_WIDTH, A_WIDTH,
             Q_LORA_RANK, KV_LORA_RANK, QK_ROPE_DIM, B_WIDTH)
IN_COLS = sum(IN_SPLITS)

kernel_name = "hybrid_dilated_swa_mla_gated"


def rmsnorm(t, gain):
    tf = t.astype(jnp.float32)
    return tf * lax.rsqrt(jnp.mean(tf * tf, axis=-1, keepdims=True) + EPS) * gain.astype(jnp.float32)


def rope(t, cos, sin):
    t1, t2 = jnp.split(t, 2, axis=-1)
    return jnp.concatenate([t1 * cos - t2 * sin, t1 * sin + t2 * cos], axis=-1)


def t5_bucket(dist):
    max_exact = REL_BUCKETS // 2
    d = jnp.maximum(dist.astype(jnp.float32), 1.0)
    large = max_exact + (jnp.log(d / max_exact) / math.log(REL_MAX_DISTANCE / max_exact)
                         * (REL_BUCKETS - max_exact)).astype(jnp.int32)
    large = jnp.minimum(large, REL_BUCKETS - 1)
    return jnp.where(dist < max_exact, dist, large)


def dilated_pattern(q, k, v, rel_bias, window, dilation):
    B, S, H, D = q.shape
    steps = window // dilation
    span = dilation * BLOCK
    Sp = -(-S // span) * span
    nb = Sp // span
    pad = ((0, 0), (0, Sp - S), (0, 0), (0, 0))

    def blocks(t):
        return jnp.pad(t, pad).reshape(B, nb, BLOCK, dilation, H, D)

    def with_prev(t):
        prev = jnp.pad(t[:, :-1], ((0, 0), (1, 0), (0, 0), (0, 0), (0, 0), (0, 0)))
        return jnp.concatenate([prev, t], axis=2)

    qb = blocks(q)
    kw = with_prev(blocks(k))
    vw = with_prev(blocks(v))

    qi = jnp.arange(BLOCK)[:, None]
    ki = jnp.arange(2 * BLOCK)[None, :]
    j = qi + BLOCK - ki
    bias = rel_bias[t5_bucket(jnp.maximum(j, 0) * dilation)]
    bias = jnp.transpose(bias, (2, 0, 1)).astype(jnp.float32)
    valid = ((j >= 0) & (j <= steps))[None] & \
        ((jnp.arange(nb)[:, None, None] > 0) | (ki >= BLOCK)[None])

    s = jnp.einsum('bnqrhd,bnkrhd->bnrhqk', qb, kw) * (A_HEAD_DIM ** -0.5) + bias
    s = jnp.where(valid[None, :, None, None], s, -jnp.inf)
    m = jnp.max(s, axis=-1, keepdims=True)
    p = jnp.exp(s - m)
    den = jnp.sum(p, axis=-1)
    den_q = jnp.transpose(den, (0, 1, 4, 2, 3))
    o = jnp.einsum('bnrhqk,bnkrhd->bnqrhd', p, vw) / den_q[..., None]
    o = o.reshape(B, Sp, H, D)[:, :S]
    m = jnp.transpose(m[..., 0], (0, 1, 4, 2, 3)).reshape(B, Sp, H)[:, :S]
    den = den_q.reshape(B, Sp, H)[:, :S]
    return o, m, den


def dilated_window_attention(q, k, v, rel_bias):
    outs, log_dens = [], []
    for window, dilation in DILATED_PATTERNS:
        o, m, den = dilated_pattern(q, k, v, rel_bias, window, dilation)
        outs.append(o)
        log_dens.append(m + jnp.log(den))
    alpha = jax.nn.softmax(jnp.stack(log_dens, axis=0), axis=0)
    return jnp.sum(alpha[..., None] * jnp.stack(outs, axis=0), axis=0)


def latent_attention(c_q, c_kv, k_rope_in, positions, q_c_gain, w_uq, kv_c_gain, w_ukv,
                     qn_gain, qr_gain, kn_gain, kr_gain):
    B, S, _ = c_q.shape
    q = jnp.matmul(rmsnorm(c_q, q_c_gain), w_uq.astype(jnp.float32))
    q = q.reshape(B, S, B_HEADS, QK_NOPE_DIM + QK_ROPE_DIM)
    kv = jnp.matmul(rmsnorm(c_kv, kv_c_gain), w_ukv.astype(jnp.float32))
    kv = kv.reshape(B, S, B_HEADS, QK_NOPE_DIM + V_HEAD_DIM)
    q_nope = rmsnorm(q[..., :QK_NOPE_DIM], qn_gain)
    q_rope = rmsnorm(q[..., QK_NOPE_DIM:], qr_gain)
    k_nope = rmsnorm(kv[..., :QK_NOPE_DIM], kn_gain)
    v = kv[..., QK_NOPE_DIM:]
    k_rope = rmsnorm(k_rope_in, kr_gain)

    inv_freq = ROPE_THETA ** (-jnp.arange(0, QK_ROPE_DIM, 2, dtype=jnp.float32) / QK_ROPE_DIM)
    ang = positions.astype(jnp.float32)[..., None] * inv_freq
    cos, sin = jnp.cos(ang), jnp.sin(ang)
    q_rope = rope(q_rope, cos[:, :, None], sin[:, :, None])
    k_rope = rope(k_rope, cos, sin)

    scale = (QK_NOPE_DIM + QK_ROPE_DIM) ** -0.5
    nb = S // BLOCK
    qn_b = q_nope.reshape(B, nb, BLOCK, B_HEADS, QK_NOPE_DIM).transpose(1, 0, 2, 3, 4)
    qr_b = q_rope.reshape(B, nb, BLOCK, B_HEADS, QK_ROPE_DIM).transpose(1, 0, 2, 3, 4)
    kpos = jnp.arange(S)

    def one_block(args):
        qn, qr, i = args
        s = (jnp.einsum('bqhd,bkhd->bhqk', qn, k_nope)
             + jnp.einsum('bqhd,bkd->bhqk', qr, k_rope)) * scale
        qpos = i * BLOCK + jnp.arange(BLOCK)
        s = jnp.where((qpos[:, None] >= kpos[None, :])[None, None], s, -jnp.inf)
        p = jax.nn.softmax(s, axis=-1)
        return jnp.einsum('bhqk,bkhd->bqhd', p, v)

    o = lax.map(one_block, (qn_b, qr_b, jnp.arange(nb)))
    return o.transpose(1, 0, 2, 3, 4).reshape(B, S, B_WIDTH)


def hybrid_layer(x, positions, rel_bias, norm_gain, w_in, a_q_gain, a_k_gain, q_c_gain, w_uq,
                 kv_c_gain, w_ukv, qn_gain, qr_gain, kn_gain, kr_gain, w_out):
    B, S, _ = x.shape
    h = rmsnorm(x, norm_gain)
    proj = jnp.matmul(h, w_in.astype(jnp.float32))
    idx = np.cumsum(IN_SPLITS)[:-1].tolist()
    q_a, k_a, v_a, z_a, c_q, c_kv, k_rope, z_b = jnp.split(proj, idx, axis=-1)

    q_a = rmsnorm(q_a.reshape(B, S, A_HEADS, A_HEAD_DIM), a_q_gain)
    k_a = rmsnorm(k_a.reshape(B, S, A_HEADS, A_HEAD_DIM), a_k_gain)
    v_a = v_a.reshape(B, S, A_HEADS, A_HEAD_DIM)
    o_a = dilated_window_attention(q_a, k_a, v_a, rel_bias).reshape(B, S, A_WIDTH)

    o_b = latent_attention(c_q, c_kv, k_rope, positions, q_c_gain, w_uq, kv_c_gain, w_ukv,
                           qn_gain, qr_gain, kn_gain, kr_gain)

    mixed = jnp.concatenate([o_a * jax.nn.silu(z_a), o_b * jax.nn.silu(z_b)], axis=-1)
    out = jnp.matmul(mixed, w_out.astype(jnp.float32))
    return (x.astype(jnp.float32) + out).astype(x.dtype)


def setup_inputs(seed: int = 0) -> dict:
    key = jax.random.key(seed)
    ks = jax.random.split(key, 18)
    f32 = jnp.float32

    def nrm(k, shape, scale):
        return jax.random.normal(k, shape, f32) * scale

    def gain(k, shape):
        return 1.0 + 0.05 * jax.random.normal(k, shape, f32)

    x = jax.random.normal(ks[0], (BATCH, SEQ, D_MODEL), f32)
    offsets = jax.random.randint(ks[1], (BATCH, 1), 0, 1024, dtype=jnp.int32)
    positions = (jnp.arange(SEQ, dtype=jnp.int32)[None, :] + offsets).astype(jnp.int32)
    return {
        "x": x,
        "positions": positions,
        "rel_bias": nrm(ks[2], (REL_BUCKETS, A_HEADS), 0.1),
        "norm_gain": gain(ks[3], (DEPTH, D_MODEL)),
        "w_in": nrm(ks[4], (DEPTH, D_MODEL, IN_COLS), D_MODEL ** -0.5),
        "a_q_gain": gain(ks[5], (DEPTH, A_HEAD_DIM)),
        "a_k_gain": gain(ks[6], (DEPTH, A_HEAD_DIM)),
        "q_c_gain": gain(ks[7], (DEPTH, Q_LORA_RANK)),
        "w_uq": nrm(ks[8], (DEPTH, Q_LORA_RANK, B_HEADS * (QK_NOPE_DIM + QK_ROPE_DIM)), Q_LORA_RANK ** -0.5),
        "kv_c_gain": gain(ks[9], (DEPTH, KV_LORA_RANK)),
        "w_ukv": nrm(ks[10], (DEPTH, KV_LORA_RANK, B_HEADS * (QK_NOPE_DIM + V_HEAD_DIM)), KV_LORA_RANK ** -0.5),
        "qn_gain": gain(ks[11], (DEPTH, QK_NOPE_DIM)),
        "qr_gain": gain(ks[12], (DEPTH, QK_ROPE_DIM)),
        "kn_gain": gain(ks[13], (DEPTH, QK_NOPE_DIM)),
        "kr_gain": gain(ks[14], (DEPTH, QK_ROPE_DIM)),
        "w_out": nrm(ks[15], (DEPTH, D_MIX, D_MODEL), D_MIX ** -0.5),
    }


def reference(x, positions, rel_bias, norm_gain, w_in, a_q_gain, a_k_gain, q_c_gain, w_uq,
              kv_c_gain, w_ukv, qn_gain, qr_gain, kn_gain, kr_gain, w_out):
    for l in range(DEPTH):
        x = hybrid_layer(x, positions, rel_bias, norm_gain[l], w_in[l], a_q_gain[l], a_k_gain[l],
                         q_c_gain[l], w_uq[l], kv_c_gain[l], w_ukv[l], qn_gain[l], qr_gain[l],
                         kn_gain[l], kr_gain[l], w_out[l])
    return x
```

```cpp
#include <hip/hip_runtime.h>
#include <cstdio>
#include <cstdint>
#include <cmath>
namespace pg8 {
#define PG8_LAS __attribute__((address_space(3)))
typedef unsigned short bf16_t;
typedef short bf16x8 __attribute__((ext_vector_type(8)));
typedef float f32x4 __attribute__((ext_vector_type(4)));
typedef unsigned u32x4 __attribute__((ext_vector_type(4)));
constexpr int BM = 256, BK = 64, HALF = 128, HTB = HALF * BK * 2  , STAGE_BYTES = 8 * HTB, NXCD = 8, WGM = 8;

__host__ __device__ __forceinline__ int lds_byte(int r, int c) { const int st = (r >> 4) * 2 + (c >> 5), rr = r & 15, cc = c & 31, ob = rr * 64 + cc * 2; return st * 1024 + (ob ^ (((ob >> 9) & 1) << 5)); }
__host__ __device__ __forceinline__ void stage_rc(int b, int& R, int& C) { const int st = b / 1024, sb = b % 1024, swz = sb ^ (((sb >> 9) & 1) << 5); R = (st >> 1) * 16 + swz / 64; C = (st & 1) * 32 + (swz % 64) / 2; }
__host__ __device__ __forceinline__ int perm32(int rho) { const int n = rho >> 4, i = rho & 15; return 8 * (i >> 2) + 4 * n + (i & 3); }

struct Unit { int pm, pn; };
struct Gemm { const bf16_t* A; const bf16_t* Bt; int M, N, K; };

struct StaticOrder {
    int nM, nN, nwg, G, c;
    __host__ __device__ void init(int M, int N, int G_, int c_) { nM = M / BM; nN = N / BM; nwg = nM * nN; G = G_; c = c_; }
    __host__ __device__ bool next(int i, Unit& u) const {
        const long L = (long)i * G + c; if (L >= nwg) return false;
        int wgid = (int)L; { const int q = nwg / NXCD, r = nwg % NXCD, xcd = wgid % NXCD, off = wgid / NXCD; wgid = (xcd < r ? xcd * (q + 1) : r * (q + 1) + (xcd - r) * q) + off; }
        const int nig = WGM * nN, gid = wgid / nig, fm = gid * WGM, gsz = (nM - fm) < WGM ? (nM - fm) : WGM;
        u.pm = fm + ((wgid % nig) % gsz); u.pn = (wgid % nig) / gsz; return true;
    }
    __device__ __forceinline__ void a_ready(const Unit&) const {}
    __device__ __forceinline__ void done(const Unit&) const {}
};


template <class Epi, class Sched, bool ALIGN_EPI = false, bool SP2 = false>
__device__ __forceinline__ void gemm_phase(PG8_LAS unsigned char* lds, const Gemm g, const Sched& S, const Epi& E) {
    int tid_ = threadIdx.x; asm volatile("" : "+v"(tid_));
    const int tid = tid_, wid = __builtin_amdgcn_readfirstlane(tid >> 6), lane = tid & 63, wr = wid >> 2, wc = wid & 3, fr = lane & 15, fq = lane >> 4;
    const int K = g.K, nt = K / BK;
    unsigned voffA[2], voffB[2];
#pragma unroll
    for (int i = 0; i < 2; ++i) { int R, C; stage_rc(tid * 16 + i * 8192, R, C); const int Rb = Epi::PERM ? ((R & ~31) + perm32(R & 31)) : R;
        voffA[i] = (unsigned)(R * K + C) * 2u; voffB[i] = (unsigned)(Rb * K + C) * 2u; }
    const size_t kstep = (size_t)(BK * 2);
    const size_t hstep = (size_t)HALF * K * 2;
    const size_t tstep = 2 * hstep;
    const unsigned ldsw = (unsigned)wid * 1024u;
    const int aoff = lds_byte(wr * 64 + fr, fq * 8), boff = lds_byte(wc * 32 + fr, fq * 8);
#define PG8_SA(b, h) (((b) * 2 + (h)) * HTB)
#define PG8_SB(b, h) ((4 + (b) * 2 + (h)) * HTB)
#define PG8_STAGE(bufoff, gbase, voff) do { _Pragma("unroll") for (int _i = 0; _i < 2; ++_i) \
        __builtin_amdgcn_global_load_lds((const unsigned*)((const char*)(gbase) + (voff)[_i]), (PG8_LAS unsigned*)(lds + (bufoff) + ldsw + _i * 8192), 16, 0, 0); } while (0)
#define PG8_LDA(dst, b, h) do { _Pragma("unroll") for (int m = 0; m < 4; ++m) _Pragma("unroll") for (int k = 0; k < 2; ++k) dst[m][k] = *(const PG8_LAS bf16x8*)(lds + PG8_SA(b, h) + aoff + m * 2048 + k * 1024); } while (0)
#define PG8_LDB(dst, b, h) do { _Pragma("unroll") for (int n = 0; n < 2; ++n) _Pragma("unroll") for (int k = 0; k < 2; ++k) dst[n][k] = *(const PG8_LAS bf16x8*)(lds + PG8_SB(b, h) + boff + n * 2048 + k * 1024); } while (0)
#define PG8_MMA(ai, bj, At, Bt) do { __builtin_amdgcn_s_setprio(1); _Pragma("unroll") for (int m = 0; m < 4; ++m) _Pragma("unroll") for (int n = 0; n < 2; ++n) _Pragma("unroll") for (int k = 0; k < 2; ++k) \
        acc[ai][bj][m][n] = __builtin_amdgcn_mfma_f32_16x16x32_bf16(Bt[n][k], At[m][k], acc[ai][bj][m][n], 0, 0, 0); __builtin_amdgcn_s_setprio(0); } while (0)
#define PG8_WAIT_V(n) asm volatile("s_waitcnt vmcnt(" #n ")" ::: "memory")
#define PG8_WAIT_L(n) asm volatile("s_waitcnt lgkmcnt(" #n ")" ::: "memory")
#define PG8_WAIT_VR(r) asm volatile("s_waitcnt vmcnt(40)\n\ts_cmp_lg_u32 %0, 0\n\ts_cbranch_scc1 .Lpg8rl%=\n\ts_waitcnt vmcnt(8)\n.Lpg8rl%=:" :: "s"(r) : "scc", "memory")
#define PG8_BAR __builtin_amdgcn_s_barrier()
#define PG8_SCHED __builtin_amdgcn_sched_barrier(0)
    Unit cur, nxt; int ui = 0; int relaxed = 0;
    if (!S.next(0, cur)) return;
    f32x4 acc[2][2][4][2];
#pragma unroll
    for (int a = 0; a < 2; ++a)
#pragma unroll
        for (int b = 0; b < 2; ++b)
#pragma unroll
            for (int m = 0; m < 4; ++m)
#pragma unroll
                for (int n = 0; n < 2; ++n) acc[a][b][m][n] = (f32x4){0.f, 0.f, 0.f, 0.f};
    if constexpr (Epi::INIT) E.init(acc, cur, wr, wc, fr, fq);
    bf16x8 At[4][2], B0[2][2], B1[2][2];
    const char* cA = (const char*)g.A + (size_t)cur.pm * tstep; const char* cB = (const char*)g.Bt + (size_t)cur.pn * tstep;
    S.a_ready(cur);
    if constexpr (SP2) {
        PG8_STAGE(PG8_SB(0, 0), cB, voffB); PG8_STAGE(PG8_SB(0, 1), cB + hstep, voffB); PG8_STAGE(PG8_SA(0, 0), cA, voffA); PG8_STAGE(PG8_SA(0, 1), cA + hstep, voffA);
        if (wr == 1) PG8_BAR;
        PG8_WAIT_V(2); PG8_BAR;
        PG8_STAGE(PG8_SB(1, 0), cB + kstep, voffB); PG8_STAGE(PG8_SA(1, 0), cA + kstep, voffA); PG8_STAGE(PG8_SB(1, 1), cB + hstep + kstep, voffB);
        PG8_WAIT_V(6); PG8_BAR;
    } else {
        PG8_STAGE(PG8_SB(0, 0), cB, voffB); PG8_STAGE(PG8_SA(0, 0), cA, voffA); PG8_STAGE(PG8_SB(0, 1), cB + hstep, voffB); PG8_STAGE(PG8_SA(0, 1), cA + hstep, voffA);
        if (wr == 1) PG8_BAR;
        PG8_WAIT_V(4); PG8_BAR;
        PG8_STAGE(PG8_SB(1, 0), cB + kstep, voffB); PG8_STAGE(PG8_SA(1, 0), cA + kstep, voffA); PG8_STAGE(PG8_SB(1, 1), cB + hstep + kstep, voffB);
        PG8_WAIT_V(6); PG8_BAR;
    }
    for (;;) {
        const bool has_next = S.next(ui + 1, nxt);
        const char* nA = has_next ? (const char*)g.A + (size_t)nxt.pm * tstep : cA; const char* nB = has_next ? (const char*)g.Bt + (size_t)nxt.pn * tstep : cB;
        for (int t = 0; t < nt; t += 2) {
            const bool last = (t == nt - 2);
            const char* a1 = cA + (size_t)(t + 1) * kstep;
            const char* a2 = last ? nA : cA + (size_t)(t + 2) * kstep; const char* b2 = last ? nB : cB + (size_t)(t + 2) * kstep;
            const char* a3 = a2 + kstep; const char* b3 = b2 + kstep;
            if (last && has_next) S.a_ready(nxt);
            if constexpr (SP2) {
            const int rl = __builtin_amdgcn_readfirstlane((t == 0) ? relaxed : 0);
            PG8_LDB(B0, 0, 0); PG8_LDB(B1, 0, 1); PG8_SCHED; PG8_LDA(At, 0, 0); PG8_STAGE(PG8_SA(1, 1), a1 + hstep, voffA);
            if constexpr (Epi::RELAX) PG8_WAIT_VR(rl); else PG8_WAIT_V(8); PG8_WAIT_L(0); PG8_BAR; PG8_MMA(0, 0, At, B0); PG8_MMA(0, 1, At, B1); PG8_BAR; PG8_SCHED;
            PG8_LDA(At, 0, 1); PG8_STAGE(PG8_SB(0, 0), b2, voffB); PG8_STAGE(PG8_SB(0, 1), b2 + hstep, voffB); PG8_STAGE(PG8_SA(0, 0), a2, voffA);
            if constexpr (Epi::RELAX) PG8_WAIT_VR(rl); else PG8_WAIT_V(8); PG8_WAIT_L(0); PG8_BAR; PG8_MMA(1, 0, At, B0); PG8_MMA(1, 1, At, B1); PG8_BAR; PG8_SCHED;
            PG8_LDB(B0, 1, 0); PG8_LDB(B1, 1, 1); PG8_SCHED; PG8_LDA(At, 1, 0); PG8_STAGE(PG8_SA(0, 1), a2 + hstep, voffA);
            if constexpr (Epi::RELAX) PG8_WAIT_VR(rl); else PG8_WAIT_V(8); PG8_WAIT_L(0); PG8_BAR; PG8_MMA(0, 0, At, B0); PG8_MMA(0, 1, At, B1); PG8_BAR; PG8_SCHED;
            PG8_LDA(At, 1, 1); PG8_STAGE(PG8_SB(1, 0), b3, voffB); PG8_STAGE(PG8_SB(1, 1), b3 + hstep, voffB); PG8_STAGE(PG8_SA(1, 0), a3, voffA);
            PG8_WAIT_V(8); PG8_WAIT_L(0); PG8_BAR; PG8_MMA(1, 0, At, B0); PG8_MMA(1, 1, At, B1); PG8_BAR; PG8_SCHED;
            } else {
            PG8_LDB(B0, 0, 0); PG8_SCHED; PG8_LDA(At, 0, 0); PG8_STAGE(PG8_SA(1, 1), a1 + hstep, voffA);
            PG8_WAIT_L(8); PG8_BAR; PG8_WAIT_L(0); PG8_MMA(0, 0, At, B0); PG8_BAR; PG8_SCHED;
            PG8_LDB(B1, 0, 1); PG8_STAGE(PG8_SB(0, 0), b2, voffB);
            PG8_BAR; PG8_WAIT_L(0); PG8_MMA(0, 1, At, B1); PG8_BAR;
            PG8_LDA(At, 0, 1); PG8_STAGE(PG8_SA(0, 0), a2, voffA);
            PG8_BAR; PG8_WAIT_L(0); PG8_MMA(1, 0, At, B0); PG8_BAR; PG8_SCHED;
            PG8_STAGE(PG8_SB(0, 1), b2 + hstep, voffB);
            PG8_WAIT_V(6); PG8_BAR; PG8_MMA(1, 1, At, B1); PG8_BAR;
            PG8_LDB(B0, 1, 0); PG8_SCHED; PG8_LDA(At, 1, 0); PG8_STAGE(PG8_SA(0, 1), a2 + hstep, voffA);
            PG8_WAIT_L(8); PG8_BAR; PG8_WAIT_L(0); PG8_MMA(0, 0, At, B0); PG8_BAR; PG8_SCHED;
            PG8_LDB(B1, 1, 1); PG8_STAGE(PG8_SB(1, 0), b3, voffB);
            PG8_BAR; PG8_WAIT_L(0); PG8_MMA(0, 1, At, B1); PG8_BAR;
            PG8_LDA(At, 1, 1); PG8_STAGE(PG8_SA(1, 0), a3, voffA);
            PG8_BAR; PG8_WAIT_L(0); PG8_MMA(1, 0, At, B0); PG8_BAR; PG8_SCHED;
            PG8_STAGE(PG8_SB(1, 1), b3 + hstep, voffB);
            PG8_WAIT_V(6); PG8_BAR; PG8_MMA(1, 1, At, B1); PG8_BAR;
            }
        }
        if constexpr (ALIGN_EPI) { if (wr == 0) PG8_BAR; }
        int relax_next = 0;
        if constexpr (ALIGN_EPI && SP2 && Epi::RELAX) { relax_next = __builtin_amdgcn_readfirstlane((has_next && nt > 2 && E.relax(cur) >= 32) ? 1 : 0);
            if (relax_next) { PG8_STAGE(PG8_SA(1, 1), nA + kstep + hstep, voffA); } PG8_SCHED; }
        if constexpr (!Epi::AFTER_DRAIN) { E(acc, cur, wr, wc, fr, fq); S.done(cur); }
        if (!has_next) break;
#pragma unroll
        for (int a = 0; a < 2; ++a)
#pragma unroll
            for (int b = 0; b < 2; ++b)
#pragma unroll
                for (int m = 0; m < 4; ++m)
#pragma unroll
                    for (int n = 0; n < 2; ++n) acc[a][b][m][n] = (f32x4){0.f, 0.f, 0.f, 0.f};
        if constexpr (Epi::INIT) E.init(acc, nxt, wr, wc, fr, fq);
        cur = nxt; cA = nA; cB = nB; ++ui; relaxed = relax_next;
        if constexpr (ALIGN_EPI) { if (wr == 1) PG8_BAR; }
    }
    PG8_WAIT_V(0);
    if constexpr (!ALIGN_EPI) { if (wr == 0) PG8_BAR; }
    PG8_BAR;
    if constexpr (Epi::AFTER_DRAIN) { E.fused(acc, cur, wr, wc, fr, fq, lds, wid, lane); S.done(cur); }
#undef PG8_SA
#undef PG8_SB
#undef PG8_STAGE
#undef PG8_LDA
#undef PG8_LDB
#undef PG8_MMA
#undef PG8_WAIT_V
#undef PG8_WAIT_L
#undef PG8_WAIT_VR
#undef PG8_BAR
#undef PG8_SCHED
}
}

constexpr int BATCH = 8, SEQ = 4096, DMODEL = 1024, M = BATCH * SEQ;
constexpr int NIN = 3072;
constexpr int QLR = 256, KVLR = 128, DQK = 96;
constexpr float EPS = 1e-6f, LOG2E = 1.4426950408889634f;
constexpr float SCALE_A = 0.125f * LOG2E;
constexpr float SCALE_B = 0.10206207261596577f * LOG2E;
constexpr int NWAVES = 8;

constexpr size_t MiB = 1u << 20;
constexpr size_t WS_CTL = 0, CTL_ZERO_BYTES = 1 * MiB;
constexpr size_t WS_WIN = 2 * MiB, WS_WUQ = 8 * MiB, WS_WUKV = 9 * MiB, WS_WOUT = 10 * MiB;
constexpr size_t WS_CS = 12 * MiB;
constexpr size_t WS_BT = 16 * MiB;
constexpr size_t WS_GN = 16 * MiB + 65536;
constexpr int GN_AQ = 0, GN_AK = 64, GN_QN = 128, GN_QR = 192, GN_KN = 224, GN_KR = 288;
constexpr size_t WS_SSQ = 17 * MiB;
constexpr size_t WS_LP = 18 * MiB;
constexpr size_t WS_KR = 22 * MiB;
constexpr size_t WS_XN = 24 * MiB;
constexpr size_t WS_CQ = 88 * MiB;
constexpr size_t WS_CKV = 104 * MiB;
constexpr size_t WS_QA = 112 * MiB, WS_KA = 144 * MiB, WS_VA = 176 * MiB;
constexpr size_t WS_SZ = 208 * MiB;
constexpr size_t WS_QB = 272 * MiB;
constexpr size_t WS_KN = 320 * MiB, WS_VB = 352 * MiB;
constexpr size_t WS_MIX = 384 * MiB;
constexpr size_t WS_OP0 = 24 * MiB, WS_OP1 = 56 * MiB, WS_OP2 = 448 * MiB;
constexpr size_t WS_END = 480 * MiB;

constexpr int CW_TMO = 0, CW_BAR = 4096;

constexpr int RING_OFF = 0, RING_BYTES = 131072;
constexpr int LDSCTL_OFF = RING_BYTES, MISC_OFF = LDSCTL_OFF + 320;
constexpr int LDS_BYTES = 163840;

#define GAS __attribute__((address_space(1)))
#define LAS __attribute__((address_space(3)))
typedef unsigned short bf16;
typedef unsigned v4u __attribute__((ext_vector_type(4)));
typedef float f32x4 __attribute__((ext_vector_type(4)));
typedef float f32x16 __attribute__((ext_vector_type(16)));
typedef short bf16x8 __attribute__((ext_vector_type(8)));
typedef short s16x4 __attribute__((ext_vector_type(4)));
typedef GAS unsigned gu32;
#define RLX_AGENT __ATOMIC_RELAXED, __HIP_MEMORY_SCOPE_AGENT
#define LDS_WAIT() asm volatile("s_waitcnt lgkmcnt(0)" ::: "memory")
#define VM_WAIT() asm volatile("s_waitcnt vmcnt(0)" ::: "memory")
typedef float f32x2_t __attribute__((ext_vector_type(2))); typedef __bf16 bf16x2_t __attribute__((ext_vector_type(2)));
__device__ __forceinline__ unsigned pk2(float lo, float hi) { f32x2_t v = {lo, hi}; bf16x2_t b = __builtin_convertvector(v, bf16x2_t); return __builtin_bit_cast(unsigned, b); }
__device__ __forceinline__ float bf2f(unsigned short b) { return __uint_as_float((unsigned)b << 16); }
__device__ __forceinline__ float bflo(unsigned w) { return __uint_as_float(w << 16); }
__device__ __forceinline__ float bfhi(unsigned w) { return __uint_as_float(w & 0xffff0000u); }
__device__ __forceinline__ int crow(int r, int hi) { return (r & 3) + 8 * (r >> 2) + 4 * hi; }

#define XB_TMO      128
#define XB_XCNT(j)  (256  + 64 * (j))
#define XB_XSUB(j)  (1280 + 64 * (j))
#define XB_XGEN(j)  (2304 + 64 * (j))
#define XB_TOP      3328
#define XB_TOPGEN   3392
#define XCD_BAR_WORDS 3456
#define XB_SPIN_CAP (1u << 18)

__device__ __forceinline__ unsigned xb_ld(unsigned* p)              { return __hip_atomic_load(p, __ATOMIC_RELAXED, __HIP_MEMORY_SCOPE_AGENT); }
__device__ __forceinline__ unsigned xb_add(unsigned* p, unsigned v) { return __hip_atomic_fetch_add(p, v, __ATOMIC_RELAXED, __HIP_MEMORY_SCOPE_AGENT); }
__device__ __forceinline__ unsigned xb_xcc_id() { return (unsigned)__builtin_amdgcn_s_getreg((3 << 11) | 20) & 0xFu; }
#define XB_SPIN(cond, bar) do { unsigned _sp = 0; while (cond) { __builtin_amdgcn_s_sleep(1); \
    if ((++_sp & 255u) == 0u) { if (xb_ld(&(bar)[XB_TMO])) break; if (_sp > XB_SPIN_CAP) { atomicAdd(&(bar)[XB_TMO], 1u); break; } } } } while (0)

struct XcdBarrier {
    unsigned* bar; unsigned x;
    volatile LAS unsigned* st;
};

__device__ __forceinline__ XcdBarrier xcd_barrier_post(unsigned* bar, volatile LAS unsigned* st) {
    XcdBarrier b; b.bar = bar; b.x = xb_xcc_id(); b.st = st;
    if (threadIdx.x == 0) (void)xb_add(&bar[XB_XCNT(b.x)], 1u);
    return b;
}
__device__ __forceinline__ void xcd_barrier_complete(unsigned* bar, unsigned x, unsigned& nloc, unsigned& nx) {
    const unsigned G = gridDim.x * gridDim.y * gridDim.z;
    unsigned sum, cnt, mine, sp = 0u;
    for (;;) {
        sum = 0u; cnt = 0u; mine = 0u;
#pragma unroll
        for (unsigned j = 0; j < 16; ++j) { const unsigned c = xb_ld(&bar[XB_XCNT(j)]); sum += c; cnt += (c > 0u) ? 1u : 0u; mine = (j == x) ? c : mine; }
        if (sum == G) break;
        __builtin_amdgcn_s_sleep(1);
        if ((++sp & 255u) == 0u) { if (xb_ld(&bar[XB_TMO])) break; if (sp > XB_SPIN_CAP) { atomicAdd(&bar[XB_TMO], 1u); break; } }
    }
    nloc = mine > 0u ? mine : 1u; nx = cnt > 0u ? cnt : 1u;
}

__device__ __forceinline__ void xcd_barrier(const XcdBarrier& b) {
    asm volatile("s_waitcnt vmcnt(0)" ::: "memory");
    __syncthreads();
    if (threadIdx.x == 0) {
        unsigned* bar = b.bar;
        __builtin_amdgcn_s_waitcnt(0);
        unsigned nloc = b.st[0], nx = b.st[1];
        if (nloc == 0u) { xcd_barrier_complete(bar, b.x, nloc, nx); b.st[0] = nloc; b.st[1] = nx; }
        const unsigned old = xb_add(&bar[XB_XSUB(b.x)], 1u);
        const unsigned gen = old / nloc;
        if (old + 1u == (gen + 1u) * nloc) {
            __builtin_amdgcn_fence(__ATOMIC_RELEASE, "agent");
            asm volatile("s_waitcnt vmcnt(0)" ::: "memory");
            const unsigned og = xb_add(&bar[XB_TOP], 1u);
            const unsigned tg = og / nx;
            if (og + 1u == (tg + 1u) * nx) xb_add(&bar[XB_TOPGEN], 1u);
            else XB_SPIN(xb_ld(&bar[XB_TOPGEN]) == tg, bar);
            __builtin_amdgcn_fence(__ATOMIC_ACQUIRE, "agent");
            xb_add(&bar[XB_XGEN(b.x)], 1u);
            asm volatile("s_waitcnt vmcnt(0)" ::: "memory");
        } else {
            XB_SPIN(xb_ld(&bar[XB_XGEN(b.x)]) == gen, bar);
            __builtin_amdgcn_fence(__ATOMIC_ACQUIRE, "agent");
            asm volatile("s_waitcnt vmcnt(0)" ::: "memory");
        }
    }
    __syncthreads();
}


struct Frame {
    LAS unsigned char* lds;
    volatile LAS unsigned* MISC;
    gu32* ctl;
    int tid, lane, wave, vcu, G;
};
struct ProIn { const float *x, *rel_bias, *norm_gain, *w_in, *qc_gain, *w_uq, *kvc_gain, *w_ukv, *w_out; const int* positions; bf16 *WinT, *WuqT, *WukvT, *WoutT, *XN; float *CS, *BT; const float *aq, *ak, *qn, *qr, *kn, *kr; float* GN; };
struct MlaT { const bf16 *QB, *KN, *KR, *VB, *SZ; bf16* MIX; };

__device__ __forceinline__ float wave_sum(float v) {
#pragma unroll
    for (int o = 1; o < 64; o <<= 1) v += __shfl_xor(v, o);
    return v;
}
__device__ __forceinline__ void wprep_item(const float* W, int ldw, int src0, bf16* WT, int K, int dst_row0, const float* gk, LAS float* scr, int kb, int lane) {
    const int k0 = 64 * kb;
    if (src0 < 0) {
#pragma unroll
        for (int j = 0; j < 4; ++j) { const int n = (lane >> 3) + 8 * j; *(GAS v4u*)(WT + (size_t)(dst_row0 + n) * K + k0 + 8 * (lane & 7)) = (v4u){0u, 0u, 0u, 0u}; }
        return;
    }
#pragma unroll 8
    for (int i = 0; i < 32; ++i) { const int kk = 2 * i + (lane >> 5); const float g = gk ? gk[k0 + kk] : 1.0f; scr[kk * 33 + (lane & 31)] = W[(size_t)(k0 + kk) * ldw + src0 + (lane & 31)] * g; }
    LDS_WAIT(); asm volatile("" ::: "memory");
    const int c = lane & 7;
#pragma unroll
    for (int j = 0; j < 4; ++j) { const int n = (lane >> 3) + 8 * j; const LAS float* s = scr + (8 * c) * 33 + n;
        v4u o; o.x = pk2(s[0 * 33], s[1 * 33]); o.y = pk2(s[2 * 33], s[3 * 33]); o.z = pk2(s[4 * 33], s[5 * 33]); o.w = pk2(s[6 * 33], s[7 * 33]);
        *(GAS v4u*)(WT + (size_t)(dst_row0 + n) * K + k0 + 8 * c) = o; }
    LDS_WAIT(); asm volatile("" ::: "memory");
}
__device__ __forceinline__ int win_src(int db) {
    const int pn = db >> 3, p0 = (db & 7) * 32, bj = p0 >> 7, wc = (p0 & 127) >> 5;
    if (pn < 10) { const int seg = pn >> 1, T = pn & 1, head = 4 * T + wc; const int base = seg == 0 ? 0 : seg == 1 ? 512 : seg == 2 ? 1024 : seg == 3 ? 1536 : 2464; return base + head * 64 + 32 * bj; }
    if (pn == 10) return 2048 + 64 * wc + 32 * bj;
    if (wc < 2) return 2304 + 64 * wc + 32 * bj;
    if (wc == 2 && bj == 0) return 2432;
    return -1;
}
__device__ __forceinline__ int wuq_src(int db) { const int job = db >> 1, nh = db & 1; return job < 8 ? job * 96 + 32 * nh : (2 * (job - 8) + nh) * 96 + 64; }
__device__ __forceinline__ int wukv_src(int db) { const int job = db >> 1, nh = db & 1; return job < 8 ? job * 128 + 32 * nh : (job - 8) * 128 + 64 + 32 * nh; }
__device__ __forceinline__ int t5_bucket(int dist) {
    if (dist < 16) return dist;
    const float d = (float)dist;
    int large = 16 + (int)(logf(d / 16.0f) / 4.852030263919617f * 16.0f);
    return large < 31 ? large : 31;
}
__device__ __forceinline__ void sincos_rev(double f, float& s, float& c) {
    const double k = rint(4.0 * f); const double y = (f - 0.25 * k) * 6.283185307179586476925287;
    const double y2 = y * y;
    const double sy = y * (1.0 + y2 * (-1.0 / 6 + y2 * (1.0 / 120 + y2 * (-1.0 / 5040 + y2 * (1.0 / 362880 + y2 * (-1.0 / 39916800 + y2 * (1.0 / 6227020800.0)))))));
    const double cy = 1.0 + y2 * (-0.5 + y2 * (1.0 / 24 + y2 * (-1.0 / 720 + y2 * (1.0 / 40320 + y2 * (-1.0 / 3628800 + y2 * (1.0 / 479001600.0 + y2 * (-1.0 / 87178291200.0)))))));
    const int q = ((int)k) & 3;
    const double ss = (q == 0) ? sy : (q == 1) ? cy : (q == 2) ? -sy : -cy;
    const double cc = (q == 0) ? cy : (q == 1) ? -sy : (q == 2) ? -cy : sy;
    s = (float)ss; c = (float)cc;
}
__device__ __forceinline__ float inv_freq(int i) {
    const int e = i >> 2, r = i & 3;
    const double m = r == 0 ? 1.0 : r == 1 ? 0.5623413251903491 : r == 2 ? 0.31622776601683794 : 0.1778279410038923;
    const double p = e == 0 ? 1.0 : e == 1 ? 0.1 : e == 2 ? 0.01 : 0.001;
    return (float)(m * p);
}
__device__ __forceinline__ void p0_prologue(const Frame& F, const ProIn P) {
    LAS float* scr = (LAS float*)(F.lds + RING_OFF + F.wave * 16384);
    const int gw = F.vcu * NWAVES + F.wave, NGW = F.G * NWAVES;
    constexpr int I_IN = (NIN / 32) * (DMODEL / 64), I_UQ = (768 / 32) * (QLR / 64), I_UKV = (1024 / 32) * (KVLR / 64), I_OUT = (1024 / 32) * (1024 / 64);
    constexpr int NITEMS = I_IN + I_UQ + I_UKV + I_OUT;
    for (int it = gw; it < NITEMS; it += NGW) {
        int r = it;
        if (r < I_IN) { const int db = r / 16, kb = r % 16; wprep_item(P.w_in, 2976, win_src(db), P.WinT, DMODEL, 32 * db, nullptr, scr, kb, F.lane); continue; } r -= I_IN;
        if (r < I_UQ) { const int db = r / 4, kb = r % 4; wprep_item(P.w_uq, 768, wuq_src(db), P.WuqT, QLR, 32 * db, P.qc_gain, scr, kb, F.lane); continue; } r -= I_UQ;
        if (r < I_UKV) { const int db = r / 2, kb = r % 2; wprep_item(P.w_ukv, 1024, wukv_src(db), P.WukvT, KVLR, 32 * db, P.kvc_gain, scr, kb, F.lane); continue; } r -= I_UKV;
        { const int db = r / 16, kb = r % 16; wprep_item(P.w_out, 1024, 32 * db, P.WoutT, 1024, 32 * db, nullptr, scr, kb, F.lane); }
    }
    if (F.vcu == 0 && F.tid < 64) { const int t = F.tid; P.GN[GN_AQ + t] = P.aq[t]; P.GN[GN_AK + t] = P.ak[t]; P.GN[GN_QN + t] = P.qn[t]; P.GN[GN_KN + t] = P.kn[t]; if (t < 32) { P.GN[GN_QR + t] = P.qr[t]; P.GN[GN_KR + t] = P.kr[t]; } }
    { f32x4 g[4];
#pragma unroll
      for (int j = 0; j < 4; ++j) g[j] = *((const GAS f32x4*)P.norm_gain + F.lane + 64 * j);
      for (int m0 = 4 * gw; m0 < M; m0 += 4 * NGW) {
        f32x4 v[4][4]; float sq[4];
#pragma unroll
        for (int r = 0; r < 4; ++r) { const GAS f32x4* xr = (const GAS f32x4*)(P.x + (size_t)(m0 + r) * DMODEL) + F.lane;
#pragma unroll
            for (int j = 0; j < 4; ++j) v[r][j] = xr[64 * j]; }
#pragma unroll
        for (int r = 0; r < 4; ++r) { float s = 0.f;
#pragma unroll
            for (int j = 0; j < 4; ++j) s += (v[r][j].x * v[r][j].x + v[r][j].y * v[r][j].y) + (v[r][j].z * v[r][j].z + v[r][j].w * v[r][j].w);
            sq[r] = s; }
#pragma unroll
        for (int o = 1; o < 64; o <<= 1) {
#pragma unroll
            for (int r = 0; r < 4; ++r) sq[r] += __shfl_xor(sq[r], o); }
#pragma unroll
        for (int r = 0; r < 4; ++r) { const float rstd = rsqrtf(sq[r] * (1.f / DMODEL) + EPS);
            GAS unsigned long long* o8 = (GAS unsigned long long*)(P.XN + (size_t)(m0 + r) * DMODEL) + F.lane;
#pragma unroll
            for (int j = 0; j < 4; ++j) o8[64 * j] = (unsigned long long)pk2(v[r][j].x * rstd * g[j].x, v[r][j].y * rstd * g[j].y) | ((unsigned long long)pk2(v[r][j].z * rstd * g[j].z, v[r][j].w * rstd * g[j].w) << 32); }
      } }
    { const int gt = F.vcu * (NWAVES * 64) + F.tid, NGT = F.G * NWAVES * 64;
      for (int e = gt; e < M * 16; e += NGT) { const int row = e >> 4, i = e & 15;
          const float ang = (float)P.positions[row] * inv_freq(i);
          const double rev = (double)ang * 0.15915494309189533576888; const double f = rev - rint(rev);
          float s, c; sincos_rev(f, s, c); P.CS[(size_t)row * 32 + i] = c; P.CS[(size_t)row * 32 + 16 + i] = s; }
      for (int e = gt; e < 3 * 8 * 192; e += NGT) { const int p = e / (8 * 192), h = (e / 192) % 8, ix = e % 192; const int delta = ix - 31; const int dil = p == 0 ? 1 : p == 1 ? 4 : 16;
          float v = -INFINITY; if (delta >= 0 && delta <= 128) v = LOG2E * P.rel_bias[t5_bucket(delta * dil) * 8 + h];
          P.BT[e] = v; }
    }
}

typedef pg8::Unit Unit;
__device__ __forceinline__ float dot4(const f32x4 a) { return (a[0] * a[0] + a[1] * a[1]) + (a[2] * a[2] + a[3] * a[3]); }
__device__ __forceinline__ float qsum(float s) { s += __shfl_xor(s, 16); s += __shfl_xor(s, 32); return s; }
__device__ __forceinline__ v4u pack8(const f32x4 a, const f32x4 b) { v4u w; w.x = pk2(a[0], a[1]); w.y = pk2(a[2], a[3]); w.z = pk2(b[0], b[1]); w.w = pk2(b[2], b[3]); return w; }
__device__ __forceinline__ float silu1(float z) { return z * __builtin_amdgcn_rcpf(1.0f + __builtin_amdgcn_exp2f(-z * LOG2E)); }
__device__ __forceinline__ f32x4 silu4(const f32x4 z) { return (f32x4){silu1(z[0]), silu1(z[1]), silu1(z[2]), silu1(z[3])}; }
__device__ __forceinline__ void rope8(f32x4& t0, f32x4& t1, const float* cs, int fq) {
    f32x4 p0, p1;
#pragma unroll
    for (int e = 0; e < 4; ++e) { p0[e] = __shfl_xor(t0[e], 32); p1[e] = __shfl_xor(t1[e], 32); }
    const f32x4 c0 = *(const f32x4*)(cs + 8 * (fq & 1)), c1 = *(const f32x4*)(cs + 8 * (fq & 1) + 4), s0 = *(const f32x4*)(cs + 16 + 8 * (fq & 1)), s1 = *(const f32x4*)(cs + 16 + 8 * (fq & 1) + 4);
    const float sg = fq < 2 ? -1.0f : 1.0f;
    t0 = t0 * c0 + sg * (p0 * s0); t1 = t1 * c1 + sg * (p1 * s1);
}

__device__ __forceinline__ unsigned swap_adj(unsigned v) { return (unsigned)__builtin_amdgcn_update_dpp(0, (int)v, 0xB1, 0xF, 0xF, false); }
__device__ __forceinline__ void store_rows2(bf16* p, int stride, const v4u A, const v4u B, int e) {
    v4u d1, d2;
#pragma unroll
    for (int k = 0; k < 4; ++k) { const unsigned snd = e ? A[k] : B[k], rcv = swap_adj(snd); d1[k] = e ? rcv : A[k]; d2[k] = e ? B[k] : rcv; }
    bf16* p1 = p + (e ? 32 - stride : 0);
    *(v4u*)p1 = d1; *(v4u*)(p1 + stride) = d2;
}
struct EpiP1 {
    static constexpr bool PERM = true, AFTER_DRAIN = false, INIT = false, RELAX = true;
    unsigned char* ws;
    __device__ __forceinline__ int relax(const Unit& u) const { return u.pn <= 10 ? 32 : 0; }
    __device__ __forceinline__ void operator()(const f32x4 (&acc)[2][2][4][2], const Unit& u, int wr, int wc, int fr_, int fq_) const {
        int t_ = threadIdx.x; asm volatile("" : "+v"(t_)); int fr = t_ & 15, fq = (t_ >> 4) & 3; (void)fr_; (void)fq_;
        bf16 *QA = (bf16*)(ws + WS_QA), *KA = (bf16*)(ws + WS_KA), *VA = (bf16*)(ws + WS_VA), *SZ = (bf16*)(ws + WS_SZ), *CQ = (bf16*)(ws + WS_CQ), *CKV = (bf16*)(ws + WS_CKV), *KR = (bf16*)(ws + WS_KR);
        float* SSQ = (float*)(ws + WS_SSQ); const float *GN = (const float*)(ws + WS_GN), *aq = GN + GN_AQ, *ak = GN + GN_AK, *krg = GN + GN_KR, *CS = (const float*)(ws + WS_CS);
        const int pn = u.pn; const int row0 = u.pm * 256 + wr * 64 + fr;
        if (pn < 4) {
            const float* g = pn < 2 ? aq : ak; const float sc = pn < 2 ? SCALE_A : 1.0f; bf16* dst = (pn < 2 ? QA : KA) + (4 * (pn & 1) + wc) * 64 + 8 * fq;
            const f32x4 g00 = *(const f32x4*)(g + 8 * fq), g01 = *(const f32x4*)(g + 8 * fq + 4), g10 = *(const f32x4*)(g + 32 + 8 * fq), g11 = *(const f32x4*)(g + 32 + 8 * fq + 4);
#pragma unroll
            for (int ai = 0; ai < 2; ++ai)
#pragma unroll
                for (int m = 0; m < 4; ++m) { const f32x4 a0 = acc[ai][0][m][0], a1 = acc[ai][0][m][1], b0 = acc[ai][1][m][0], b1 = acc[ai][1][m][1];
                    const float ss = qsum((dot4(a0) + dot4(a1)) + (dot4(b0) + dot4(b1))); const float rs = rsqrtf(ss * (1.0f / 64.0f) + EPS) * sc;
                    bf16* p = dst + (size_t)(row0 + ai * 128 + m * 16) * 512;
                    store_rows2(p, 512, pack8(a0 * g00 * rs, a1 * g01 * rs), pack8(b0 * g10 * rs, b1 * g11 * rs), fr & 1); }
        } else if (pn < 6) {
            bf16* dst = VA + (4 * (pn & 1) + wc) * 64 + 8 * fq;
#pragma unroll
            for (int ai = 0; ai < 2; ++ai)
#pragma unroll
                for (int m = 0; m < 4; ++m) { bf16* p = dst + (size_t)(row0 + ai * 128 + m * 16) * 512;
                    store_rows2(p, 512, pack8(acc[ai][0][m][0], acc[ai][0][m][1]), pack8(acc[ai][1][m][0], acc[ai][1][m][1]), fr & 1); }
        } else if (pn < 10) {
            bf16* dst = SZ + (pn - 6) * 256 + wc * 64 + 8 * fq;
#pragma unroll
            for (int ai = 0; ai < 2; ++ai)
#pragma unroll
                for (int m = 0; m < 4; ++m) { bf16* p = dst + (size_t)(row0 + ai * 128 + m * 16) * 1024;
                    store_rows2(p, 1024, pack8(silu4(acc[ai][0][m][0]), silu4(acc[ai][0][m][1])), pack8(silu4(acc[ai][1][m][0]), silu4(acc[ai][1][m][1])), fr & 1); }
        } else if (pn == 10) {
            bf16* dst = CQ + wc * 64 + 8 * fq;
#pragma unroll
            for (int ai = 0; ai < 2; ++ai)
#pragma unroll
                for (int m = 0; m < 4; ++m) { const f32x4 a0 = acc[ai][0][m][0], a1 = acc[ai][0][m][1], b0 = acc[ai][1][m][0], b1 = acc[ai][1][m][1]; const int row = row0 + ai * 128 + m * 16;
                    const float ss = qsum((dot4(a0) + dot4(a1)) + (dot4(b0) + dot4(b1))); if (fq == 0) SSQ[(size_t)row * 8 + wc] = ss;
                    bf16* p = dst + (size_t)row * 256; store_rows2(p, 256, pack8(a0, a1), pack8(b0, b1), fr & 1); }
        } else {
            if (wc < 2) {
                bf16* dst = CKV + wc * 64 + 8 * fq;
#pragma unroll
                for (int ai = 0; ai < 2; ++ai)
#pragma unroll
                    for (int m = 0; m < 4; ++m) { const f32x4 a0 = acc[ai][0][m][0], a1 = acc[ai][0][m][1], b0 = acc[ai][1][m][0], b1 = acc[ai][1][m][1]; const int row = row0 + ai * 128 + m * 16;
                        const float ss = qsum((dot4(a0) + dot4(a1)) + (dot4(b0) + dot4(b1))); if (fq == 0) SSQ[(size_t)row * 8 + 4 + wc] = ss;
                        bf16* p = dst + (size_t)row * 128; store_rows2(p, 128, pack8(a0, a1), pack8(b0, b1), fr & 1); }
            } else if (wc == 2) {
                const f32x4 g0 = *(const f32x4*)(krg + 8 * fq), g1 = *(const f32x4*)(krg + 8 * fq + 4);
#pragma unroll
                for (int ai = 0; ai < 2; ++ai)
#pragma unroll
                    for (int m = 0; m < 4; ++m) { const f32x4 a0 = acc[ai][0][m][0], a1 = acc[ai][0][m][1]; const int row = row0 + ai * 128 + m * 16;
                        const float ss = qsum(dot4(a0) + dot4(a1)); const float rs = rsqrtf(ss * (1.0f / 32.0f) + EPS);
                        f32x4 t0 = a0 * g0 * rs, t1 = a1 * g1 * rs; rope8(t0, t1, CS + (size_t)row * 32, fq);
                        *(v4u*)(KR + (size_t)row * 32 + 8 * fq) = pack8(t0, t1); }
            }
        }
    }
};
struct EpiP2q {
    static constexpr bool PERM = true, AFTER_DRAIN = false, INIT = false;
    unsigned char* ws;
    __device__ __forceinline__ void operator()(const f32x4 (&acc)[2][2][4][2], const Unit& u, int wr, int wc, int fr_, int fq_) const {
        int fr = fr_, fq = fq_; asm volatile("" : "+v"(fr), "+v"(fq));
        bf16* QB = (bf16*)(ws + WS_QB); const float *SSQ = (const float*)(ws + WS_SSQ), *GN = (const float*)(ws + WS_GN), *qn = GN + GN_QN, *qr = GN + GN_QR, *CS = (const float*)(ws + WS_CS);
        const int pn = u.pn; const int row0 = u.pm * 256 + wr * 64 + fr;
        if (pn < 2) {
            bf16* dst = QB + (4 * pn + wc) * 96 + 8 * fq;
            const f32x4 g00 = *(const f32x4*)(qn + 8 * fq), g01 = *(const f32x4*)(qn + 8 * fq + 4), g10 = *(const f32x4*)(qn + 32 + 8 * fq), g11 = *(const f32x4*)(qn + 32 + 8 * fq + 4);
#pragma unroll
            for (int ai = 0; ai < 2; ++ai)
#pragma unroll
                for (int m = 0; m < 4; ++m) { const int row = row0 + ai * 128 + m * 16; const f32x4 sq = *(const f32x4*)(SSQ + (size_t)row * 8);
                    const float rc = rsqrtf(((sq[0] + sq[1]) + (sq[2] + sq[3])) * (1.0f / 256.0f) + EPS);
                    const f32x4 a0 = acc[ai][0][m][0] * rc, a1 = acc[ai][0][m][1] * rc, b0 = acc[ai][1][m][0] * rc, b1 = acc[ai][1][m][1] * rc;
                    const float ss = qsum((dot4(a0) + dot4(a1)) + (dot4(b0) + dot4(b1))); const float rs = rsqrtf(ss * (1.0f / 64.0f) + EPS) * SCALE_B;
                    bf16* p = dst + (size_t)row * 768; *(v4u*)p = pack8(a0 * g00 * rs, a1 * g01 * rs); *(v4u*)(p + 32) = pack8(b0 * g10 * rs, b1 * g11 * rs); asm volatile("" ::: "memory"); }
        } else {
            const f32x4 g0 = *(const f32x4*)(qr + 8 * fq), g1 = *(const f32x4*)(qr + 8 * fq + 4);
#pragma unroll
            for (int ai = 0; ai < 2; ++ai)
#pragma unroll
                for (int m = 0; m < 4; ++m) { const int row = row0 + ai * 128 + m * 16; const f32x4 sq = *(const f32x4*)(SSQ + (size_t)row * 8);
                    const float rc = rsqrtf(((sq[0] + sq[1]) + (sq[2] + sq[3])) * (1.0f / 256.0f) + EPS);
#pragma unroll
                    for (int bj = 0; bj < 2; ++bj) { const f32x4 a0 = acc[ai][bj][m][0] * rc, a1 = acc[ai][bj][m][1] * rc;
                        const float ss = qsum(dot4(a0) + dot4(a1)); const float rs = rsqrtf(ss * (1.0f / 32.0f) + EPS);
                        f32x4 t0 = a0 * g0 * rs, t1 = a1 * g1 * rs; rope8(t0, t1, CS + (size_t)row * 32, fq);
                        *(v4u*)(QB + (size_t)row * 768 + (2 * wc + bj) * 96 + 64 + 8 * fq) = pack8(t0 * SCALE_B, t1 * SCALE_B); asm volatile("" ::: "memory"); } }
        }
    }
};
struct EpiP2kv {
    static constexpr bool PERM = true, AFTER_DRAIN = false, INIT = false;
    unsigned char* ws;
    __device__ __forceinline__ void operator()(const f32x4 (&acc)[2][2][4][2], const Unit& u, int wr, int wc, int fr_, int fq_) const {
        int fr = fr_, fq = fq_; asm volatile("" : "+v"(fr), "+v"(fq));
        bf16 *KN = (bf16*)(ws + WS_KN), *VB = (bf16*)(ws + WS_VB); const float *SSQ = (const float*)(ws + WS_SSQ), *kn = (const float*)(ws + WS_GN) + GN_KN;
        const int pn = u.pn; const int row0 = u.pm * 256 + wr * 64 + fr;
        bf16* dst = (pn < 2 ? KN : VB) + (4 * (pn & 1) + wc) * 64 + 8 * fq;
        f32x4 g00 = (f32x4){1.f, 1.f, 1.f, 1.f}, g01 = g00, g10 = g00, g11 = g00;
        if (pn < 2) { g00 = *(const f32x4*)(kn + 8 * fq); g01 = *(const f32x4*)(kn + 8 * fq + 4); g10 = *(const f32x4*)(kn + 32 + 8 * fq); g11 = *(const f32x4*)(kn + 32 + 8 * fq + 4); }
#pragma unroll
        for (int ai = 0; ai < 2; ++ai)
#pragma unroll
            for (int m = 0; m < 4; ++m) { const int row = row0 + ai * 128 + m * 16;
                const float rc = rsqrtf((SSQ[(size_t)row * 8 + 4] + SSQ[(size_t)row * 8 + 5]) * (1.0f / 128.0f) + EPS);
                const f32x4 a0 = acc[ai][0][m][0] * rc, a1 = acc[ai][0][m][1] * rc, b0 = acc[ai][1][m][0] * rc, b1 = acc[ai][1][m][1] * rc;
                float rs = 1.0f;
                if (pn < 2) { const float ss = qsum((dot4(a0) + dot4(a1)) + (dot4(b0) + dot4(b1))); rs = rsqrtf(ss * (1.0f / 64.0f) + EPS); }
                bf16* p = dst + (size_t)row * 512; *(v4u*)p = pack8(a0 * g00 * rs, a1 * g01 * rs); *(v4u*)(p + 32) = pack8(b0 * g10 * rs, b1 * g11 * rs); asm volatile("" ::: "memory"); }
    }
};
struct EpiOut {
    static constexpr bool PERM = false, AFTER_DRAIN = false, INIT = true, RELAX = false;
    const float* x; float* out;
    __device__ __forceinline__ int relax(const Unit&) const { return 0; }
    __device__ __forceinline__ void init(f32x4 (&acc)[2][2][4][2], const Unit& u, int wr, int wc, int fr_, int fq_) const {
        int fr = fr_, fq = fq_; asm volatile("" : "+v"(fr), "+v"(fq));
        const int row0 = u.pm * 256 + wr * 64 + fr, col0 = u.pn * 256 + wc * 32 + 4 * fq;
#pragma unroll
        for (int ai = 0; ai < 2; ++ai)
#pragma unroll
            for (int m = 0; m < 4; ++m) { const size_t off = (size_t)(row0 + ai * 128 + m * 16) * 1024 + col0;
#pragma unroll
                for (int bj = 0; bj < 2; ++bj)
#pragma unroll
                    for (int n = 0; n < 2; ++n) acc[ai][bj][m][n] = *(const f32x4*)(x + off + bj * 128 + n * 16); }
    }
    __device__ __forceinline__ void operator()(const f32x4 (&acc)[2][2][4][2], const Unit& u, int wr, int wc, int fr_, int fq_) const {
        int fr = fr_, fq = fq_; asm volatile("" : "+v"(fr), "+v"(fq));
        const int row0 = u.pm * 256 + wr * 64 + fr, col0 = u.pn * 256 + wc * 32 + 4 * fq;
#pragma unroll
        for (int ai = 0; ai < 2; ++ai)
#pragma unroll
            for (int m = 0; m < 4; ++m) { const size_t off = (size_t)(row0 + ai * 128 + m * 16) * 1024 + col0;
#pragma unroll
                for (int bj = 0; bj < 2; ++bj)
#pragma unroll
                    for (int n = 0; n < 2; ++n) *(f32x4*)(out + off + bj * 128 + n * 16) = acc[ai][bj][m][n]; }
    }
};

typedef LAS const char* lds_cptr;
typedef short v4i16_t __attribute__((ext_vector_type(4)));
__device__ __forceinline__ s16x4 vtr(lds_cptr p) { return __builtin_bit_cast(s16x4, __builtin_amdgcn_ds_read_tr16_b64_v4i16((LAS v4i16_t*)p)); }
#define MFMA32(a, b, c) __builtin_amdgcn_mfma_f32_32x32x16_bf16(a, b, c, 0, 0, 0)
__device__ __forceinline__ float half_swap_add(float v) { auto rr = __builtin_amdgcn_permlane32_swap(__float_as_uint(v), __float_as_uint(v), false, false); return __uint_as_float(rr[0]) + __uint_as_float(rr[1]); }

namespace mla2 {
constexpr int KSLOT = 12288, VSLOT = 8192, NSLOT = 3;
constexpr int LDS_K = 0, LDS_V = NSLOT * KSLOT, LDS_WS = LDS_V + NSLOT * VSLOT, LDS_OST = LDS_WS + NWAVES * 256, LDS_SZ = LDS_OST + NWAVES * 4096, LDS_TOTAL = LDS_SZ + NWAVES * 4096;
#define SBAR() __builtin_amdgcn_sched_barrier(0)
#define PIN(x) asm volatile("" : "+v"(x))
#define WAIT_BAR(N) asm volatile("s_waitcnt vmcnt(" #N ") lgkmcnt(0)\n\ts_barrier" ::: "memory")
__device__ __forceinline__ void glds16s(const void* sbase, unsigned voff, unsigned lds_base) {
    unsigned sv; asm volatile("s_mov_b32 %0, m0\n\ts_mov_b32 m0, %3\n\ts_nop 0\n\tglobal_load_lds_dwordx4 %1, %2\n\ts_mov_b32 m0, %0" : "=&s"(sv) : "v"(voff), "s"(sbase), "s"(lds_base) : "memory"); }
__device__ __forceinline__ void kload2(bf16x8* kf, lds_cptr kp, int d0) { kf[2 * d0] = *(const LAS bf16x8*)(kp + d0 * 2048); kf[2 * d0 + 1] = *(const LAS bf16x8*)(kp + d0 * 2048 + 512); }
__device__ __forceinline__ void cmask(f32x16& p0, f32x16& p1, int jb, int qrel, int hi) {
    const int kb = 64 * jb + 4 * hi;
#pragma unroll
    for (int r = 0; r < 16; ++r) { const int kv = kb + (r & 3) + 8 * (r >> 2); if (kv > qrel) p0[r] = -INFINITY; if (kv + 32 > qrel) p1[r] = -INFINITY; } }

__device__ __forceinline__ void unit(int b, int h, int qb, const MlaT T, char* lds) {
    const int tid = threadIdx.x, lane = tid & 63, r32 = lane & 31, hi = lane >> 5; const int wid = __builtin_amdgcn_readfirstlane(tid >> 6);
    const long rowbase = (long)b * SEQ; const int q0 = qb * 256, NT = (q0 + 256) / 64;
    const bf16* Qw = T.QB + (rowbase + q0 + wid * 32) * 768 + h * 96;
    const unsigned lds0 = (unsigned)(uintptr_t)lds;
    const bf16* const kbn = T.KN + rowbase * 512 + h * 64; const bf16* const kbr = T.KR + rowbase * 32; const bf16* const vbs = T.VB + rowbase * 512 + h * 64;
    const unsigned kon = (unsigned)lane * 1024u + (unsigned)wid * 16u, kor = (unsigned)lane * 64u + (unsigned)(wid & 3) * 16u;
    const unsigned vof = (unsigned)(16 * (wid & 3) + (lane >> 2)) * 1024u + (unsigned)(wid >> 2) * 64u + (unsigned)(lane & 3) * 16u;
    const unsigned kdn = lds0 + LDS_K + wid * 1024, kdr = lds0 + LDS_K + (8 + (wid & 3)) * 1024, vdst = lds0 + LDS_V + wid * 1024;
#define DMA_K(t, slot) do { glds16s(kbn + (long)(t) * 64 * 512, kon, (unsigned)__builtin_amdgcn_readfirstlane(kdn + (slot))); glds16s(kbr + (long)(t) * 64 * 32, kor, (unsigned)__builtin_amdgcn_readfirstlane(kdr + (slot))); } while (0)
#define DMA_V(t, slot) glds16s(vbs + (long)(t) * 64 * 512, vof, (unsigned)__builtin_amdgcn_readfirstlane(vdst + (slot)))
    const lds_cptr vp0 = (lds_cptr)lds + LDS_V + ((lane >> 4) & 1) * 32 + (lane & 3) * 8 + (4 * hi + ((lane & 15) >> 2)) * 64;
    const lds_cptr kp0 = (lds_cptr)lds + LDS_K + hi * 1024 + r32 * 16;
    DMA_K(0, 0); DMA_V(0, 0); DMA_K(1, KSLOT);
    bf16x8 qr[6];
#pragma unroll
    for (int d0 = 0; d0 < 6; ++d0) qr[d0] = *reinterpret_cast<const bf16x8*>(&Qw[(long)r32 * 768 + d0 * 16 + hi * 8]);
    float l_reg = 0.f; f32x16 o[2]; o[0] = f32x16{}; o[1] = f32x16{};
    const f32x16 zero16 = f32x16{};
    const int qrel = wid * 32 + r32;
    f32x16 pA0, pA1, pB0, pB1; bf16x8 kf[12]; s16x4 vlo[8], vhi[8]; v4u pw0, pw1, pw2, pw3;
    int ks_cur = 0, ks_next = KSLOT, vs_prev = 0, vs_cur = 0, vs_next = VSLOT;
#define ROT() do { ks_cur = ks_next; ks_next = (ks_next == 2 * KSLOT) ? 0 : ks_next + KSLOT; vs_prev = vs_cur; vs_cur = vs_next; vs_next = (vs_next == 2 * VSLOT) ? 0 : vs_next + VSLOT; } while (0)
#define EX(v) __builtin_amdgcn_exp2f(v)
    DMA_K(2, 2 * KSLOT);
    WAIT_BAR(5);
#pragma unroll
    for (int d0 = 0; d0 < 6; ++d0) kload2(kf, kp0, d0);
    pA0 = MFMA32(kf[0], qr[0], zero16); pA1 = MFMA32(kf[1], qr[0], zero16);
#pragma unroll
    for (int d0 = 1; d0 < 6; ++d0) { pA0 = MFMA32(kf[2 * d0], qr[d0], pA0); pA1 = MFMA32(kf[2 * d0 + 1], qr[d0], pA1); }
    if (NT == 4) cmask(pA0, pA1, 0, qrel, hi);
#pragma unroll
    for (int r = 0; r < 16; ++r) { pA0[r] = EX(pA0[r]); pA1[r] = EX(pA1[r]); }
    WAIT_BAR(0);
    DMA_K(3, 0); DMA_V(1, VSLOT); ROT();
#pragma unroll
    for (int d0 = 0; d0 < 6; ++d0) kload2(kf, kp0 + ks_cur, d0);
    WAIT_BAR(3);
    { const bf16* zb = T.SZ + (rowbase + q0 + wid * 32) * 1024 + 512 + h * 64; const unsigned zo = (unsigned)(lane >> 3) * 2048u + (unsigned)(lane & 7) * 16u;
#pragma unroll
      for (int i = 0; i < 4; ++i) glds16s(zb + (long)(8 * i) * 1024, zo, (unsigned)__builtin_amdgcn_readfirstlane(lds0 + LDS_SZ + wid * 4096 + i * 1024)); }
#define PKW(P, i) pk2(P[i], P[i + 1])
#define PAF(k) __builtin_bit_cast(bf16x8, pw##k)
#define VFR(i) (bf16x8){vlo[i][0], vlo[i][1], vlo[i][2], vlo[i][3], vhi[i][0], vhi[i][1], vhi[i][2], vhi[i][3]}
#define VRD(i) do { vlo[i] = vtr(vp_ + (((i) >> 2) * 4096 + ((i) & 3) * 1024)); vhi[i] = vtr(vp_ + (((i) >> 2) * 4096 + ((i) & 3) * 1024 + 512)); } while (0)
#define KRD(G, d0) do { if (G) { kload2(kf, kp0 + ks_next, d0); SBAR(); } } while (0)
#define GA3(MF, a0, a1, a2, WW, PW) do { MF; sacc += a0; sacc += a1; sacc += a2; WW; PIN(PW); PIN(sacc); SBAR(); } while (0)
#define GAPB(MF, X, i) do { MF; X[i] = EX(X[i]); X[i + 1] = EX(X[i + 1]); X[i + 2] = EX(X[i + 2]); X[i + 3] = EX(X[i + 3]); PIN(X); SBAR(); } while (0)
#define STEP(C0, C1, P0, P1, t, MASK, GK, GV, GL) do { SBAR(); \
    const lds_cptr vp_ = vp0 + vs_prev; \
    VRD(0); SBAR(); float sacc = P0[0] + P0[1]; \
                    GA3(C0 = MFMA32(kf[0], qr[0], zero16), P0[2], P0[3], P0[4],   pw0[0] = PKW(P0, 0); pw0[1] = PKW(P0, 2),   pw0); \
    VRD(4); SBAR(); GA3(C1 = MFMA32(kf[1], qr[0], zero16), P0[5], P0[6], P0[7],   pw0[2] = PKW(P0, 4); pw0[3] = PKW(P0, 6),   pw0); \
    VRD(1); SBAR(); GA3(C0 = MFMA32(kf[2], qr[1], C0),     P0[8], P0[9], P0[10],  pw1[0] = PKW(P0, 8); pw1[1] = PKW(P0, 10),  pw1); \
    VRD(5); SBAR(); GA3(C1 = MFMA32(kf[3], qr[1], C1),     P0[11], P0[12], P0[13], pw1[2] = PKW(P0, 12); pw1[3] = PKW(P0, 14), pw1); \
    VRD(2); SBAR(); GA3(C0 = MFMA32(kf[4], qr[2], C0),     P0[14], P0[15], P1[0], pw2[0] = PKW(P1, 0),  pw2); \
    VRD(6); SBAR(); GA3(C1 = MFMA32(kf[5], qr[2], C1),     P1[1], P1[2], P1[3],   pw2[1] = PKW(P1, 2),  pw2); \
    VRD(3); SBAR(); GA3(C0 = MFMA32(kf[6], qr[3], C0),     P1[4], P1[5], P1[6],   pw2[2] = PKW(P1, 4),  pw2); \
    VRD(7); SBAR(); GA3(C1 = MFMA32(kf[7], qr[3], C1),     P1[7], P1[8], P1[9],   pw2[3] = PKW(P1, 6),  pw2); \
                    GA3(C0 = MFMA32(kf[8], qr[4], C0),     P1[10], P1[11], P1[12], pw3[0] = PKW(P1, 8),  pw3); \
                    GA3(C1 = MFMA32(kf[9], qr[4], C1),     P1[13], P1[14], P1[15], pw3[1] = PKW(P1, 10), pw3); \
                    GA3(C0 = MFMA32(kf[10], qr[5], C0),    0.f, 0.f, 0.f,          pw3[2] = PKW(P1, 12), pw3); \
                    GA3(C1 = MFMA32(kf[11], qr[5], C1),    0.f, 0.f, 0.f,          pw3[3] = PKW(P1, 14), pw3); \
    l_reg += sacc; \
    if (GK) DMA_K((t) + 3, ks_cur); if (GV) DMA_V((t) + 1, vs_next); \
    if (MASK) cmask(C0, C1, (t) - (NT - 4), qrel, hi); \
    SBAR(); \
    GAPB(o[0] = MFMA32(PAF(0), VFR(0), o[0]), C0, 0);              KRD(GL, 0); GAPB(o[1] = MFMA32(PAF(0), VFR(4), o[1]), C0, 4); \
    KRD(GL, 1); GAPB(o[0] = MFMA32(PAF(1), VFR(1), o[0]), C0, 8);  KRD(GL, 2); GAPB(o[1] = MFMA32(PAF(1), VFR(5), o[1]), C0, 12); \
    KRD(GL, 3); GAPB(o[0] = MFMA32(PAF(2), VFR(2), o[0]), C1, 0);  KRD(GL, 4); GAPB(o[1] = MFMA32(PAF(2), VFR(6), o[1]), C1, 4); \
    KRD(GL, 5); GAPB(o[0] = MFMA32(PAF(3), VFR(3), o[0]), C1, 8);              GAPB(o[1] = MFMA32(PAF(3), VFR(7), o[1]), C1, 12); \
    } while (0)
    int t = 1;
    for (; t + 5 < NT; t += 2) {
        STEP(pB0, pB1, pA0, pA1, t, false, true, true, true);     WAIT_BAR(3); ROT();
        STEP(pA0, pA1, pB0, pB1, t + 1, false, true, true, true); WAIT_BAR(3); ROT();
    }
#define ENDW(tt) do { if ((tt) + 3 < NT) { WAIT_BAR(3); } else if ((tt) + 2 < NT) { WAIT_BAR(1); } else { WAIT_BAR(0); } } while (0)
    for (; t + 1 < NT; t += 2) {
        STEP(pB0, pB1, pA0, pA1, t, (t >= NT - 4), (t + 3 < NT), (t + 1 < NT), (t + 1 < NT));         ENDW(t);     ROT();
        STEP(pA0, pA1, pB0, pB1, t + 1, (t + 1 >= NT - 4), (t + 4 < NT), (t + 2 < NT), (t + 2 < NT)); ENDW(t + 1); ROT();
    }
    STEP(pB0, pB1, pA0, pA1, NT - 1, true, false, false, false);
    { float sacc = pB0[0] + pB0[1];
#pragma unroll
      for (int r = 2; r < 16; ++r) sacc += pB0[r];
#pragma unroll
      for (int r = 0; r < 16; ++r) sacc += pB1[r];
      l_reg += sacc;
      pw0 = (v4u){PKW(pB0, 0), PKW(pB0, 2), PKW(pB0, 4), PKW(pB0, 6)}; pw1 = (v4u){PKW(pB0, 8), PKW(pB0, 10), PKW(pB0, 12), PKW(pB0, 14)};
      pw2 = (v4u){PKW(pB1, 0), PKW(pB1, 2), PKW(pB1, 4), PKW(pB1, 6)}; pw3 = (v4u){PKW(pB1, 8), PKW(pB1, 10), PKW(pB1, 12), PKW(pB1, 14)};
      SBAR();
      const lds_cptr vp_ = vp0 + vs_cur;
#pragma unroll
      for (int i = 0; i < 8; ++i) VRD(i);
      o[0] = MFMA32(PAF(0), VFR(0), o[0]); o[1] = MFMA32(PAF(0), VFR(4), o[1]); o[0] = MFMA32(PAF(1), VFR(1), o[0]); o[1] = MFMA32(PAF(1), VFR(5), o[1]);
      o[0] = MFMA32(PAF(2), VFR(2), o[0]); o[1] = MFMA32(PAF(2), VFR(6), o[1]); o[0] = MFMA32(PAF(3), VFR(3), o[0]); o[1] = MFMA32(PAF(3), VFR(7), o[1]); }
    l_reg = half_swap_add(l_reg);
    int ln = lane; asm volatile("" : "+v"(ln));
    const int r32e = ln & 31, hie = ln >> 5;
    LAS float* wsf = (LAS float*)((LAS unsigned char*)lds + LDS_WS) + wid * 64;
    if (hie == 0) wsf[r32e] = l_reg;
    asm volatile("s_waitcnt lgkmcnt(0)" ::: "memory");
    float rli[16];
#pragma unroll
    for (int r = 0; r < 16; ++r) rli[r] = __builtin_amdgcn_rcpf(wsf[crow(r, hie)]);
    { LAS float* stg = (LAS float*)((LAS unsigned char*)lds + LDS_OST) + wid * 1024;
      const size_t obase = (size_t)(rowbase + q0 + wid * 32) * 1024 + 512 + h * 64;
#pragma unroll
      for (int d0 = 0; d0 < 2; ++d0) {
#pragma unroll
          for (int r = 0; r < 16; ++r) stg[crow(r, hie) * 32 + r32e] = o[d0][r] * rli[r];
          asm volatile("s_waitcnt lgkmcnt(0)" ::: "memory");
#pragma unroll
          for (int i = 0; i < 4; ++i) { const int row = i * 8 + (ln >> 3), ch = ln & 7; const f32x4 v = *(const LAS f32x4*)(stg + row * 32 + ch * 4);
              const size_t off = obase + (size_t)row * 1024 + d0 * 32 + ch * 4;
              const unsigned long long z = *(const LAS unsigned long long*)((LAS unsigned char*)lds + LDS_SZ + wid * 4096 + row * 128 + (d0 * 32 + ch * 4) * 2); const unsigned zl = (unsigned)z, zh = (unsigned)(z >> 32);
              const unsigned long long w = (unsigned long long)pk2(v[0] * bflo(zl), v[1] * bfhi(zl)) | ((unsigned long long)pk2(v[2] * bflo(zh), v[3] * bfhi(zh)) << 32);
              *(unsigned long long*)(T.MIX + off) = w; }
          asm volatile("s_waitcnt lgkmcnt(0)" ::: "memory");
      } }
    asm volatile("s_waitcnt lgkmcnt(0)\n\ts_barrier" ::: "memory");
#undef DMA_K
#undef DMA_V
#undef ROT
#undef EX
#undef PKW
#undef PAF
#undef VFR
#undef VRD
#undef KRD
#undef GA3
#undef GAPB
#undef STEP
#undef ENDW
}
#undef SBAR
#undef PIN
#undef WAIT_BAR
}

namespace dil4 {
constexpr int SLOT = 8192, WAVE_LDS = 2 * SLOT;
constexpr int TBC = 208;
constexpr int TB_OFF = 132096, WSF_OFF = TB_OFF + 3 * 4 * TBC * 4;
__device__ __forceinline__ void glds16s(const void* sbase, unsigned voff, unsigned lds_base) {
    unsigned sv; asm volatile("s_mov_b32 %0, m0\n\ts_mov_b32 m0, %3\n\ts_nop 0\n\tglobal_load_lds_dwordx4 %1, %2\n\ts_mov_b32 m0, %0" : "=&s"(sv) : "v"(voff), "s"(sbase), "s"(lds_base) : "memory"); }
struct T4 { const bf16 *QA, *KA, *VA; bf16 *OP0, *OP1, *OP2; float* LP; const float* BT; };
__device__ __forceinline__ void build_tables(const float* BT, int h, LAS unsigned char* lds) {
    LAS float* tb = (LAS float*)(lds + TB_OFF);
    for (int e = threadIdx.x; e < 3 * 4 * 192; e += NWAVES * 64) { const int p = e / 768, c = (e / 192) & 3, i = e % 192, ix = 190 - i - c; tb[(p * 4 + c) * TBC + i] = ix >= 0 ? BT[p * (8 * 192) + h * 192 + ix] : -INFINITY; }
}

template <int DIL>
__device__ __forceinline__ void run_task2(int s, int a0, long rowbase, int h, const T4& T, LAS unsigned char* wl, unsigned wl0, const LAS float* tbl, f32x16 (&oA)[2], f32x16 (&oB)[2], float& lA, float& lB, int lane) {
    const int r32 = lane & 31, hi = lane >> 5;
    const bf16* const kb = T.KA + rowbase * 512 + h * 64; const bf16* const vb = T.VA + rowbase * 512 + h * 64;
    unsigned kof[4], vof[4];
#pragma unroll
    for (int i = 0; i < 4; ++i) { const int row = 8 * i + (lane >> 3), ch = (lane & 7) ^ ((row >> 1) & 7); kof[i] = (unsigned)(row * DIL) * 1024u + (unsigned)ch * 16u;
        const int pc = (lane & 7) ^ (((row >> 1) & 1) << 2); vof[i] = (unsigned)(row * DIL) * 1024u + (unsigned)pc * 16u; }
    const int k0 = a0 >= 128 ? 0 : (128 - a0) >> 5;
#define DMA_SUB(k) do { const long tok = (long)(a0 - 128 + 32 * (k)) * DIL + s; const bf16* kbj = kb + tok * 512; const bf16* vbj = vb + tok * 512; const unsigned dst = wl0 + ((k) & 1) * SLOT; \
        _Pragma("unroll") for (int i = 0; i < 4; ++i) glds16s(kbj, kof[i], (unsigned)__builtin_amdgcn_readfirstlane(dst + i * 1024)); \
        _Pragma("unroll") for (int i = 0; i < 4; ++i) glds16s(vbj, vof[i], (unsigned)__builtin_amdgcn_readfirstlane(dst + 4096 + i * 1024)); } while (0)
    { const bf16* qbs = T.QA + (rowbase + (long)a0 * DIL + s) * 512 + h * 64;
#pragma unroll
      for (int i = 0; i < 8; ++i) glds16s(qbs + (long)(8 * (i & ~1)) * DIL * 512, kof[i & 1], (unsigned)__builtin_amdgcn_readfirstlane(wl0 + SLOT + i * 1024)); }
    DMA_SUB(k0);
    asm volatile("s_waitcnt vmcnt(8)" ::: "memory");
    bf16x8 qa[4], qb[4];
    { const LAS unsigned char* qs = wl + SLOT + r32 * 128;
#pragma unroll
      for (int d0 = 0; d0 < 4; ++d0) { qa[d0] = *(const LAS bf16x8*)(qs + (((2 * d0 + hi) ^ ((r32 >> 1) & 7)) * 16)); qb[d0] = *(const LAS bf16x8*)(qs + 4096 + (((2 * d0 + hi) ^ ((r32 >> 1) & 7)) * 16)); } }
    asm volatile("s_waitcnt lgkmcnt(0)" ::: "memory");
    DMA_SUB(k0 + 1);
    oA[0] = f32x16{}; oA[1] = f32x16{}; oB[0] = f32x16{}; oB[1] = f32x16{}; lA = 0.f; lB = 0.f;
    const int kro = r32 * 128, ksw = (r32 >> 1) & 7;
    const int vq = (lane & 15) >> 2, vsw = (vq >> 1) & 1;
    const lds_cptr vp0 = (lds_cptr)wl + 4096 + (4 * hi + vq) * 128 + ((lane >> 4) & 1) * 32 + (lane & 3) * 8;
#define GRP(O, L, Q, j) do { \
        f32x16 pj; { const LAS f32x4* bp = (const LAS f32x4*)(tbl + 32 * (j)); const f32x4 b0 = bp[0], b1 = bp[2], b2 = bp[4], b3 = bp[6]; \
          pj = (f32x16){b0[0], b0[1], b0[2], b0[3], b1[0], b1[1], b1[2], b1[3], b2[0], b2[1], b2[2], b2[3], b3[0], b3[1], b3[2], b3[3]}; } \
        _Pragma("unroll") for (int d0 = 0; d0 < 4; ++d0) pj = MFMA32(kf[d0], Q[d0], pj); \
        float sm = 0.f; \
        _Pragma("unroll") for (int r = 0; r < 16; ++r) { pj[r] = __builtin_amdgcn_exp2f(pj[r]); sm += pj[r]; } \
        L += sm; \
        v4u pw0, pw1; \
        _Pragma("unroll") for (int jj = 0; jj < 4; ++jj) { pw0[jj] = pk2(pj[2 * jj], pj[2 * jj + 1]); pw1[jj] = pk2(pj[8 + 2 * jj], pj[8 + 2 * jj + 1]); } \
        _Pragma("unroll") for (int dh = 0; dh < 2; ++dh) { O[dh] = MFMA32(__builtin_bit_cast(bf16x8, pw0), vf[dh][0], O[dh]); O[dh] = MFMA32(__builtin_bit_cast(bf16x8, pw1), vf[dh][1], O[dh]); } } while (0)
#define COMPUTE2(k) do { if ((k) >= k0) { \
        if ((k) < 5) asm volatile("s_waitcnt vmcnt(8)" ::: "memory"); else asm volatile("s_waitcnt vmcnt(0)" ::: "memory"); \
        const LAS unsigned char* ks = wl + ((k) & 1) * SLOT; \
        bf16x8 kf[4], vf[2][2]; \
        _Pragma("unroll") for (int d0 = 0; d0 < 4; ++d0) kf[d0] = *(const LAS bf16x8*)(ks + kro + (((2 * d0 + hi) ^ ksw) * 16)); \
        { const lds_cptr vp = vp0 + ((k) & 1) * SLOT; \
          _Pragma("unroll") for (int dh = 0; dh < 2; ++dh) { const lds_cptr vd = vp + ((dh ^ vsw) * 64); const s16x4 l0 = vtr(vd), h0 = vtr(vd + 1024), l1 = vtr(vd + 2048), h1 = vtr(vd + 3072); \
              vf[dh][0] = (bf16x8){l0[0], l0[1], l0[2], l0[3], h0[0], h0[1], h0[2], h0[3]}; vf[dh][1] = (bf16x8){l1[0], l1[1], l1[2], l1[3], h1[0], h1[1], h1[2], h1[3]}; } } \
        if ((k) <= 4) GRP(oA, lA, qa, (k)); \
        if ((k) >= 1) GRP(oB, lB, qb, (k) - 1); \
        asm volatile("s_waitcnt lgkmcnt(0)" ::: "memory"); \
        if ((k) + 2 <= 5) DMA_SUB((k) + 2); } } while (0)
    COMPUTE2(0); COMPUTE2(1); COMPUTE2(2); COMPUTE2(3); COMPUTE2(4); COMPUTE2(5);
#undef COMPUTE2
#undef GRP
#undef DMA_SUB
    lA = half_swap_add(lA); lB = half_swap_add(lB);
}
template <int DIL, int P>
__device__ __forceinline__ void store_group(const f32x16 (&o)[2], float l, int s, int a0, long rowbase, int h, const T4& T, LAS float* stg, LAS float* wsf, int lane) {
    const int r32 = lane & 31, hi = lane >> 5;
    if (hi == 0) wsf[r32] = l;
    asm volatile("s_waitcnt lgkmcnt(0)" ::: "memory");
#pragma unroll
    for (int dh = 0; dh < 2; ++dh) {
#pragma unroll
        for (int r = 0; r < 16; ++r) stg[crow(r, hi) * 32 + r32] = o[dh][r];
        asm volatile("s_waitcnt lgkmcnt(0)" ::: "memory");
#pragma unroll
        for (int i = 0; i < 4; ++i) { const int row = i * 8 + (lane >> 3), ch = lane & 7; const f32x4 v = *(const LAS f32x4*)(stg + row * 32 + ch * 4);
            const size_t tok = (size_t)(rowbase + (long)(a0 + row) * DIL + s); const size_t off = tok * 512 + h * 64 + dh * 32 + ch * 4;
            bf16* OP = P == 0 ? T.OP0 : P == 1 ? T.OP1 : T.OP2;
            *(unsigned long long*)(OP + off) = (unsigned long long)pk2(v[0], v[1]) | ((unsigned long long)pk2(v[2], v[3]) << 32);
            if (dh == 0 && ch == 0) T.LP[((size_t)P * M + tok) * 8 + h] = wsf[row]; }
        asm volatile("s_waitcnt lgkmcnt(0)" ::: "memory");
    }
}
template <int DIL, int P>
__device__ __forceinline__ void task2(int bh, int s, int a0, const T4 T, LAS unsigned char* lds) {
    const int tid = threadIdx.x; int lane = tid & 63; asm volatile("" : "+v"(lane)); const int wid = __builtin_amdgcn_readfirstlane(tid >> 6);
    const int r32 = lane & 31, hi = lane >> 5;
    const int b = bh >> 3, h = bh & 7; const long rowbase = (long)b * SEQ;
    LAS unsigned char* wl = lds + wid * WAVE_LDS; const unsigned wl0 = (unsigned)(uintptr_t)(lds) + wid * WAVE_LDS;
    const int ub = r32 - 4 * hi, cpy = (31 - ub) & 3; const LAS float* tlane = (const LAS float*)(lds + TB_OFF) + (P * 4 + cpy) * TBC + (31 - ub - cpy);
    f32x16 oA[2], oB[2]; float lA, lB;
    run_task2<DIL>(s, a0, rowbase, h, T, wl, wl0, tlane, oA, oB, lA, lB, lane);
    LAS float* wsf = (LAS float*)(lds + WSF_OFF) + wid * 32;
    LAS float* stg = (LAS float*)wl;
    store_group<DIL, P>(oA, lA, s, a0, rowbase, h, T, stg, wsf, lane);
    store_group<DIL, P>(oB, lB, s, a0 + 32, rowbase, h, T, stg, wsf, lane);
}
}

namespace dil5 {
using dil4::TBC; using dil4::TB_OFF; using dil4::WSF_OFF; using dil4::glds16s; using dil4::T4;
constexpr int LK = 0, LV = 49152, LST = 98304, CNT_OFF = LDSCTL_OFF + 768;
__device__ __forceinline__ bool chunk_ready(const volatile LAS unsigned* cnt, int ck, unsigned target) { const unsigned v = (unsigned)__builtin_amdgcn_readfirstlane((int)cnt[ck]); return (int)(v - target) >= 0; }

template <int DIL, int P>
__device__ __forceinline__ void segment(int bh, int s, int a0, unsigned target, const T4 T, LAS unsigned char* lds) {
    const int tid = threadIdx.x; int lane = tid & 63; asm volatile("" : "+v"(lane)); const int wid = __builtin_amdgcn_readfirstlane(tid >> 6);
    const int r32 = lane & 31, hi = lane >> 5;
    const int b = bh >> 3, h = bh & 7; const long rowbase = (long)b * SEQ;
    const unsigned lds0 = (unsigned)(uintptr_t)lds;
    asm volatile("s_waitcnt lgkmcnt(0)\n\ts_barrier" ::: "memory");
    const int cmin = a0 == 0 ? 2 : 0;
    { const int lr = lane >> 3;
      const bf16* qb = T.QA + (rowbase + (long)(a0 + 32 * wid) * DIL + s) * 512 + h * 64;
      const unsigned q0 = (unsigned)(lr * DIL) * 1024u + (unsigned)((lane & 7) ^ (lr >> 1)) * 16u, q1 = (unsigned)((8 + lr) * DIL) * 1024u + (unsigned)((lane & 7) ^ (4 + (lr >> 1))) * 16u;
#pragma unroll
      for (int i = 0; i < 4; ++i) glds16s(qb + (long)(8 * (i & ~1)) * DIL * 512, (i & 1) ? q1 : q0, (unsigned)__builtin_amdgcn_readfirstlane(lds0 + LST + wid * 4096 + i * 1024));
      const unsigned kw = (unsigned)(lr * DIL) * 1024u + (unsigned)((lane & 7) ^ ((4 * (wid & 1) + (lr >> 1)) & 7)) * 16u;
      const unsigned vw = (unsigned)(lr * DIL) * 1024u + (unsigned)((lane & 7) ^ (((lr >> 1) & 1) << 2)) * 16u;
      const bf16* kb = T.KA + (rowbase + (long)(a0 - 128 + 8 * wid) * DIL + s) * 512 + h * 64; const bf16* vb = T.VA + (rowbase + (long)(a0 - 128 + 8 * wid) * DIL + s) * 512 + h * 64;
#pragma unroll
      for (int c = 0; c < 6; ++c) if (c >= cmin) {
          glds16s(kb + (long)(64 * c) * DIL * 512, kw, (unsigned)__builtin_amdgcn_readfirstlane(lds0 + LK + (64 * c + 8 * wid) * 128));
          glds16s(vb + (long)(64 * c) * DIL * 512, vw, (unsigned)__builtin_amdgcn_readfirstlane(lds0 + LV + (64 * c + 8 * wid) * 128)); } }
    if (cmin) asm volatile("s_waitcnt vmcnt(8)" ::: "memory"); else asm volatile("s_waitcnt vmcnt(12)" ::: "memory");
    bf16x8 qr[4];
    { const LAS unsigned char* qs = lds + LST + wid * 4096 + r32 * 128;
#pragma unroll
      for (int d0 = 0; d0 < 4; ++d0) qr[d0] = *(const LAS bf16x8*)(qs + (((2 * d0 + hi) ^ ((r32 >> 1) & 7)) * 16)); }
    f32x16 o[2]; o[0] = f32x16{}; o[1] = f32x16{}; float l = 0.f;
    const int ub = r32 - 4 * hi, cpy = (31 - ub) & 3;
    const LAS float* tlane = (const LAS float*)(lds + TB_OFF) + (P * 4 + cpy) * TBC + (31 - ub - cpy);
    const int ksw = (r32 >> 1) & 7;
    const LAS unsigned char* kl = lds + LK + r32 * 128;
    const int vq = (lane & 15) >> 2, vsw = (vq >> 1) & 1;
    const lds_cptr vl = (lds_cptr)lds + LV + (4 * hi + vq) * 128 + ((lane >> 4) & 1) * 32 + (lane & 3) * 8;
    volatile LAS unsigned* cnt = (volatile LAS unsigned*)(lds + CNT_OFF);
#define COMPUTE(jv) do { const int sub = wid + (jv);                   \
        f32x16 pj; { const LAS f32x4* bp = (const LAS f32x4*)(tlane + 32 * (jv)); const f32x4 b0 = bp[0], b1 = bp[2], b2 = bp[4], b3 = bp[6]; \
          pj = (f32x16){b0[0], b0[1], b0[2], b0[3], b1[0], b1[1], b1[2], b1[3], b2[0], b2[1], b2[2], b2[3], b3[0], b3[1], b3[2], b3[3]}; } \
        const LAS unsigned char* ks = kl + sub * 4096; \
        bf16x8 kf[4], vf[2][2]; \
        _Pragma("unroll") for (int d0 = 0; d0 < 4; ++d0) kf[d0] = *(const LAS bf16x8*)(ks + (((2 * d0 + hi) ^ ksw) * 16)); \
        { const lds_cptr vp = vl + sub * 4096; \
          _Pragma("unroll") for (int dh = 0; dh < 2; ++dh) { const lds_cptr vd = vp + ((dh ^ vsw) * 64); const s16x4 l0 = vtr(vd), h0 = vtr(vd + 1024), l1 = vtr(vd + 2048), h1 = vtr(vd + 3072); \
              vf[dh][0] = (bf16x8){l0[0], l0[1], l0[2], l0[3], h0[0], h0[1], h0[2], h0[3]}; vf[dh][1] = (bf16x8){l1[0], l1[1], l1[2], l1[3], h1[0], h1[1], h1[2], h1[3]}; } } \
        _Pragma("unroll") for (int d0 = 0; d0 < 4; ++d0) pj = MFMA32(kf[d0], qr[d0], pj); \
        float sm = 0.f; \
        _Pragma("unroll") for (int r = 0; r < 16; ++r) { pj[r] = __builtin_amdgcn_exp2f(pj[r]); sm += pj[r]; } \
        l += sm; \
        v4u pw0, pw1; \
        _Pragma("unroll") for (int jj = 0; jj < 4; ++jj) { pw0[jj] = pk2(pj[2 * jj], pj[2 * jj + 1]); pw1[jj] = pk2(pj[8 + 2 * jj], pj[8 + 2 * jj + 1]); } \
        _Pragma("unroll") for (int dh = 0; dh < 2; ++dh) { o[dh] = MFMA32(__builtin_bit_cast(bf16x8, pw0), vf[dh][0], o[dh]); o[dh] = MFMA32(__builtin_bit_cast(bf16x8, pw1), vf[dh][1], o[dh]); } } while (0)
    int jn = a0 == 0 ? (wid >= 4 ? 0 : 4 - wid) : 0;
#define CH(c, N) do { if ((c) >= cmin) asm volatile("s_waitcnt vmcnt(" #N ")" ::: "memory"); \
        if (lane == 0) __hip_atomic_fetch_add((LAS unsigned*)(lds + CNT_OFF) + (c), 1u, __ATOMIC_RELAXED, __HIP_MEMORY_SCOPE_WORKGROUP); \
        while (jn <= 4) { const int ck = (wid + jn) >> 1; if (ck > (c) || !chunk_ready(cnt, ck, target)) break; asm volatile("" ::: "memory"); COMPUTE(jn); ++jn; } } while (0)
    CH(0, 10); CH(1, 8); CH(2, 6); CH(3, 4); CH(4, 2); CH(5, 0);
#undef CH
#pragma unroll 1
    while (jn <= 4) { const int ck = (wid + jn) >> 1; while (!chunk_ready(cnt, ck, target)) __builtin_amdgcn_s_sleep(1); asm volatile("" ::: "memory"); COMPUTE(jn); ++jn; }
#undef COMPUTE
    l = half_swap_add(l);
    LAS float* wsf = (LAS float*)(lds + WSF_OFF) + wid * 32;
    LAS float* stg = (LAS float*)(lds + LST + wid * 4096);
    dil4::store_group<DIL, P>(o, l, s, a0 + 32 * wid, rowbase, h, T, stg, wsf, lane);
}
}

namespace dil6 {
using dil4::TBC; using dil4::TB_OFF; using dil4::WSF_OFF; using dil4::glds16s; using dil4::T4;
constexpr int NS = 7, LA = 5, PA = 2, CSLOT = 16384;
constexpr int STG_LO = NS * CSLOT, STG_HI = WSF_OFF + 1024, CNT_OFF = LDSCTL_OFF + 768;
static_assert(STG_LO + 4 * 4096 <= LDSCTL_OFF && STG_HI + 4 * 4096 <= LDS_BYTES, "LDS map");
#define VMW_CASE(i) case i: asm volatile("s_waitcnt vmcnt(" #i ")" ::: "memory"); break;
__device__ __forceinline__ void vm_wait_le(int n) {
    switch (n > 15 ? 15 : n) { VMW_CASE(0) VMW_CASE(1) VMW_CASE(2) VMW_CASE(3) VMW_CASE(4) VMW_CASE(5) VMW_CASE(6) VMW_CASE(7) VMW_CASE(8) VMW_CASE(9) VMW_CASE(10) VMW_CASE(11) VMW_CASE(12) VMW_CASE(13) VMW_CASE(14) VMW_CASE(15) } }
#undef VMW_CASE
__device__ __forceinline__ bool cnt_ge(const volatile LAS unsigned* p, unsigned target) { const unsigned v = (unsigned)__builtin_amdgcn_readfirstlane((int)*p); return (int)(v - target) >= 0; }

template <int DIL, int P>
__device__ __forceinline__ void run(int bh, int s0, int a0r, int& slot, unsigned& occ, const T4 T, LAS unsigned char* lds) {
    const int tid = threadIdx.x; int lane = tid & 63; asm volatile("" : "+v"(lane)); const int wid = __builtin_amdgcn_readfirstlane(tid >> 6);
    const int r32 = lane & 31, hi = lane >> 5, lr = lane >> 3;
    const int b = bh >> 3, h = bh & 7; const long rowbase = (long)b * SEQ;
    const unsigned lds0 = (unsigned)(uintptr_t)lds;
    const int stg_off = wid < 4 ? STG_LO + wid * 4096 : STG_HI + (wid - 4) * 4096;
    const unsigned q0 = (unsigned)(lr * DIL) * 1024u + (unsigned)((lane & 7) ^ (lr >> 1)) * 16u, q1 = (unsigned)((8 + lr) * DIL) * 1024u + (unsigned)((lane & 7) ^ (4 + (lr >> 1))) * 16u;
    const unsigned kw = (unsigned)(lr * DIL) * 1024u + (unsigned)((lane & 7) ^ ((4 * (wid & 1) + (lr >> 1)) & 7)) * 16u;
    const unsigned vw = (unsigned)(lr * DIL) * 1024u + (unsigned)((lane & 7) ^ (((lr >> 1) & 1) << 2)) * 16u;
    const bf16* const kbase = T.KA + rowbase * 512 + h * 64; const bf16* const vbase = T.VA + rowbase * 512 + h * 64; const bf16* const qbase = T.QA + rowbase * 512 + h * 64;
    const int g0 = (P == 2 || a0r == 0) ? 2 : 0;
    volatile LAS unsigned* const rdy = (volatile LAS unsigned*)(lds + CNT_OFF); volatile LAS unsigned* const dne = (volatile LAS unsigned*)(lds + CNT_OFF + 32);
    int D = 0, Dq = 0; unsigned long long hist = 0;
    int ls = slot; unsigned lo = occ;
#define CHUNK_TOK(g) (P == 2 ? (long)(64 * (((g) - 2) & 3) + 8 * wid) * 16 + (s0 + (((g) - 2) >> 2)) : (long)(a0r - 128 + 64 * (g) + 8 * wid) * DIL + s0)
#define ISSUE_CHUNK(g) do { while (!cnt_ge(dne + ls, 8u * lo)) __builtin_amdgcn_s_sleep(1); asm volatile("" ::: "memory"); \
        const long tok_ = CHUNK_TOK(g); const unsigned dst_ = (unsigned)__builtin_amdgcn_readfirstlane(lds0 + ls * CSLOT + wid * 1024); \
        glds16s(kbase + tok_ * 512, kw, dst_); glds16s(vbase + tok_ * 512, vw, dst_ + 8192); D += 2; if (++ls == NS) { ls = 0; ++lo; } } while (0)
#define ISSUE_Q(k) do { const long tok_ = P == 2 ? (long)(32 * wid) * 16 + (s0 + (k)) : (long)(a0r + 256 * (k) + 32 * wid) * DIL + s0; const bf16* qb_ = qbase + tok_ * 512; \
        _Pragma("unroll") for (int i_ = 0; i_ < 4; ++i_) glds16s(qb_ + (long)(8 * (i_ & ~1)) * DIL * 512, (i_ & 1) ? q1 : q0, (unsigned)__builtin_amdgcn_readfirstlane(lds0 + stg_off + i_ * 1024)); D += 4; Dq = D; } while (0)
    ISSUE_Q(0);
#pragma unroll 1
    for (int gl = g0; gl < g0 + LA; ++gl) { ISSUE_CHUNK(gl); hist = (hist << 8) | (unsigned)(D & 255); }
    bf16x8 qr[4], qn[4]; f32x16 o[2]; float l = 0.f;
    qr[0] = qr[1] = qr[2] = qr[3] = bf16x8{}; qn[0] = qn[1] = qn[2] = qn[3] = bf16x8{}; o[0] = f32x16{}; o[1] = f32x16{};
    const int ub = r32 - 4 * hi, cpy = (31 - ub) & 3;
    const LAS float* tlane = (const LAS float*)(lds + TB_OFF) + (P * 4 + cpy) * TBC + (31 - ub - cpy);
    const int ksw = (r32 >> 1) & 7;
    const int vq = (lane & 15) >> 2, vsw = (vq >> 1) & 1;
    const int klane = r32 * 128, vlane = 8192 + (4 * hi + vq) * 128 + ((lane >> 4) & 1) * 32 + (lane & 3) * 8;
#define COMPUTE(jv, par) do { \
        f32x16 pj; { const LAS f32x4* bp = (const LAS f32x4*)(tlane + 32 * (jv)); const f32x4 b0 = bp[0], b1 = bp[2], b2 = bp[4], b3 = bp[6]; \
          pj = (f32x16){b0[0], b0[1], b0[2], b0[3], b1[0], b1[1], b1[2], b1[3], b2[0], b2[1], b2[2], b2[3], b3[0], b3[1], b3[2], b3[3]}; } \
        const LAS unsigned char* ks = lds + slot * CSLOT + (par) * 4096 + klane; \
        bf16x8 kf[4], vf[2][2]; \
        _Pragma("unroll") for (int d0 = 0; d0 < 4; ++d0) kf[d0] = *(const LAS bf16x8*)(ks + (((2 * d0 + hi) ^ ksw) * 16)); \
        { const lds_cptr vp = (lds_cptr)lds + slot * CSLOT + (par) * 4096 + vlane; \
          _Pragma("unroll") for (int dh = 0; dh < 2; ++dh) { const lds_cptr vd = vp + ((dh ^ vsw) * 64); const s16x4 l0 = vtr(vd), h0 = vtr(vd + 1024), l1 = vtr(vd + 2048), h1 = vtr(vd + 3072); \
              vf[dh][0] = (bf16x8){l0[0], l0[1], l0[2], l0[3], h0[0], h0[1], h0[2], h0[3]}; vf[dh][1] = (bf16x8){l1[0], l1[1], l1[2], l1[3], h1[0], h1[1], h1[2], h1[3]}; } } \
        _Pragma("unroll") for (int d0 = 0; d0 < 4; ++d0) pj = MFMA32(kf[d0], qr[d0], pj); \
        float sm = 0.f; \
        _Pragma("unroll") for (int r = 0; r < 16; ++r) { pj[r] = __builtin_amdgcn_exp2f(pj[r]); sm += pj[r]; } \
        l += sm; \
        v4u pw0, pw1; \
        _Pragma("unroll") for (int jj = 0; jj < 4; ++jj) { pw0[jj] = pk2(pj[2 * jj], pj[2 * jj + 1]); pw1[jj] = pk2(pj[8 + 2 * jj], pj[8 + 2 * jj + 1]); } \
        _Pragma("unroll") for (int dh = 0; dh < 2; ++dh) { o[dh] = MFMA32(vf[dh][0], __builtin_bit_cast(bf16x8, pw0), o[dh]); o[dh] = MFMA32(vf[dh][1], __builtin_bit_cast(bf16x8, pw1), o[dh]); } } while (0)
#pragma unroll 1
    for (int g = g0; g < 18; ++g) {
        if (g + LA < 18) ISSUE_CHUNK(g + LA);
        hist = (hist << 8) | (unsigned)(D & 255);
        if (g + PA < 18) {
            vm_wait_le((D - (int)((hist >> (8 * (LA - PA))) & 255)) & 255);
            if (g == g0) {
#pragma unroll
                for (int t = 0; t < PA; ++t) { const int sp = slot + t >= NS ? slot + t - NS : slot + t; if (lane == 0) __hip_atomic_fetch_add((LAS unsigned*)(lds + CNT_OFF) + sp, 1u, __ATOMIC_RELAXED, __HIP_MEMORY_SCOPE_WORKGROUP); } }
            const int sp = slot + PA >= NS ? slot + PA - NS : slot + PA;
            if (lane == 0) __hip_atomic_fetch_add((LAS unsigned*)(lds + CNT_OFF) + sp, 1u, __ATOMIC_RELAXED, __HIP_MEMORY_SCOPE_WORKGROUP);
        }
        const int d = g - (wid >> 1);
        if (d >= 0 && d < 16 && (d & 3) != 3) {
            const int k = d >> 2, m = d & 3, c = g - 4 * k;
            const int jmin = (P == 2 || (a0r == 0 && k == 0)) ? (wid >= 4 ? 0 : 4 - wid) : 0;
            if (m == 0 || g == g0) {
                if (k == 0) {
                    vm_wait_le((D - Dq) & 255);
                    const LAS unsigned char* qs = lds + stg_off + r32 * 128;
#pragma unroll
                    for (int d0 = 0; d0 < 4; ++d0) qr[d0] = *(const LAS bf16x8*)(qs + (((2 * d0 + hi) ^ ((r32 >> 1) & 7)) * 16));
                    asm volatile("s_waitcnt lgkmcnt(0)" ::: "memory");
                } else {
#pragma unroll
                    for (int d0 = 0; d0 < 4; ++d0) qr[d0] = qn[d0];
                }
                o[0] = f32x16{}; o[1] = f32x16{}; l = 0.f;
                if (k < 3) ISSUE_Q(k + 1);
            }
            while (!cnt_ge(rdy + slot, 8u * (occ + 1u))) __builtin_amdgcn_s_sleep(1);
            asm volatile("" ::: "memory");
            const int j0 = 2 * c - wid, j1 = j0 + 1;
            if (j0 >= jmin && j0 >= 0 && j0 <= 4) COMPUTE(j0, 0);
            if (j1 >= jmin && j1 >= 0 && j1 <= 4) COMPUTE(j1, 1);
            if (m == 2) {
                if (k < 3) {
                    vm_wait_le((D - Dq) & 255);
                    const LAS unsigned char* qs = lds + stg_off + r32 * 128;
#pragma unroll
                    for (int d0 = 0; d0 < 4; ++d0) qn[d0] = *(const LAS bf16x8*)(qs + (((2 * d0 + hi) ^ ((r32 >> 1) & 7)) * 16));
                    asm volatile("s_waitcnt lgkmcnt(0)" ::: "memory");
                }
                l = half_swap_add(l);
                const int s_ = P == 2 ? s0 + k : s0, a_ = P == 2 ? 32 * wid : a0r + 256 * k + 32 * wid;
                { LAS unsigned char* const sw = lds + stg_off + r32 * 128 + ((hi ^ (r32 >> 4)) & 1) * 8; const int rsw = (r32 >> 1) & 7;
#pragma unroll
                  for (int dh = 0; dh < 2; ++dh)
#pragma unroll
                      for (int g4 = 0; g4 < 4; ++g4) *(LAS unsigned long long*)(sw + (((dh * 4 + g4) ^ rsw) * 16)) = (unsigned long long)pk2(o[dh][4 * g4], o[dh][4 * g4 + 1]) | ((unsigned long long)pk2(o[dh][4 * g4 + 2], o[dh][4 * g4 + 3]) << 32); }
                asm volatile("s_waitcnt lgkmcnt(0)" ::: "memory");
                bf16* const OPb = (P == 0 ? T.OP0 : P == 1 ? T.OP1 : T.OP2) + h * 64 + (lane & 7) * 8;
#pragma unroll
                for (int it = 0; it < 4; ++it) { const int row = 8 * it + (lane >> 3);
                    const v4u x = *(const LAS v4u*)(lds + stg_off + row * 128 + (((lane & 7) ^ ((row >> 1) & 7)) * 16));
                    const v4u y = it >= 2 ? (v4u){x[2], x[3], x[0], x[1]} : x;
                    const size_t tok = (size_t)(rowbase + (long)(a_ + row) * DIL + s_);
                    asm volatile("global_store_dwordx4 %0, %1, off\n\ts_nop 1" :: "v"(OPb + tok * 512), "v"(y) : "memory"); }
                { const size_t tok = (size_t)(rowbase + (long)(a_ + r32) * DIL + s_);
                  asm volatile("global_store_dword %0, %1, off" :: "v"(T.LP + ((size_t)P * M + tok) * 8 + h), "v"(l) : "memory"); }
                asm volatile("s_waitcnt lgkmcnt(0)" ::: "memory");
            }
        }
        asm volatile("s_waitcnt lgkmcnt(0)" ::: "memory");
        if (lane == 0) __hip_atomic_fetch_add((LAS unsigned*)(lds + CNT_OFF + 32) + slot, 1u, __ATOMIC_RELAXED, __HIP_MEMORY_SCOPE_WORKGROUP);
        if (++slot == NS) { slot = 0; ++occ; }
    }
#undef COMPUTE
#undef ISSUE_Q
#undef ISSUE_CHUNK
#undef CHUNK_TOK
}
}


namespace p2c {
constexpr int WSLOT = 32768, STG = 132096, GT = STG + 8 * 2048;
constexpr int GT_QN = 0, GT_QR = 64, GT_KN = 96;
struct T2 { const bf16 *CQ, *CKV, *WQ, *WKV; const float *SSQ, *GN, *CS; bf16 *QB, *KN, *VB; };
__device__ __forceinline__ void glds16s(const void* sbase, unsigned voff, unsigned lds_base) {
    unsigned sv; asm volatile("s_mov_b32 %0, m0\n\ts_mov_b32 m0, %3\n\ts_nop 0\n\tglobal_load_lds_dwordx4 %1, %2\n\ts_mov_b32 m0, %0" : "=&s"(sv) : "v"(voff), "s"(sbase), "s"(lds_base) : "memory"); }
struct Packed { unsigned w[8]; };
__device__ __forceinline__ void pack_tile(Packed& p, const f32x16& a) {
#pragma unroll
    for (int i = 0; i < 8; ++i) p.w[i] = pk2(a[2 * i], a[2 * i + 1]);
}
__device__ __forceinline__ void flush_tile(const Packed& p, LAS unsigned char* stg, bf16* dst0, int pitch, int lane) {
    const int r32 = lane & 31, hi = lane >> 5;
#pragma unroll
    for (int g = 0; g < 4; ++g) { const int c8 = 2 * g + hi;
        *(LAS unsigned long long*)(stg + r32 * 64 + (((c8 >> 1) ^ (r32 & 3)) * 16) + (c8 & 1) * 8) = (unsigned long long)p.w[2 * g] | ((unsigned long long)p.w[2 * g + 1] << 32); }
    asm volatile("s_waitcnt lgkmcnt(0)" ::: "memory");
#pragma unroll
    for (int i = 0; i < 2; ++i) { const int row = i * 16 + (lane >> 2), ch = lane & 3; const v4u v = *(const LAS v4u*)(stg + row * 64 + ((ch ^ (row & 3)) * 16));
        *(v4u*)(dst0 + (size_t)row * pitch + ch * 8) = v; }
    asm volatile("s_waitcnt lgkmcnt(0)" ::: "memory");
}
__device__ __forceinline__ void unit(int u, const T2 T, LAS unsigned char* lds) {
    int tid = threadIdx.x; asm volatile("" : "+v"(tid));
    const int lane = tid & 63; const int wid = __builtin_amdgcn_readfirstlane(tid >> 6);
    const int r32 = lane & 31, hi = lane >> 5, rg = wid & 3, jh = wid >> 2, h4 = wid & 3;
    const unsigned lds0 = (unsigned)(uintptr_t)lds;
    const size_t tok0 = (size_t)u * 128 + rg * 32, tok = tok0 + r32;
    const int rq0 = 2 * h4 + (lane >> 5), rk0 = 4 * h4 + (lane >> 4);
    const unsigned vq0 = (unsigned)rq0 * 512u + (unsigned)((lane & 31) ^ rq0) * 16u;
    const unsigned vk0 = (unsigned)rk0 * 256u + (unsigned)((lane & 15) ^ rk0) * 16u;
    const unsigned wbuf = lds0 + jh * 2 * WSLOT + h4 * 1024;
#define DMA_Q(s) do { unsigned dst_ = wbuf + ((s) & 1) * WSLOT; const bf16* wb_ = T.WQ + (size_t)(6 * jh + (s)) * 64 * 256; unsigned v_ = vq0; asm volatile("" : "+v"(v_)); \
        _Pragma("unroll 1") for (int i = 0; i < 8; ++i) { glds16s(wb_, v_, (unsigned)__builtin_amdgcn_readfirstlane(dst_)); wb_ += 2048; dst_ += 4096; v_ ^= 128u; } } while (0)
#define DMA_KV(s) do { unsigned dst_ = wbuf + ((s) & 1) * WSLOT; const bf16* wb_ = T.WKV + (size_t)(8 * jh + (s) - 6) * 64 * 128; unsigned v_ = vk0; asm volatile("" : "+v"(v_)); \
        _Pragma("unroll 1") for (int i = 0; i < 4; ++i) { glds16s(wb_, v_, (unsigned)__builtin_amdgcn_readfirstlane(dst_)); wb_ += 2048; dst_ += 4096; } } while (0)
    bf16x8 aq[16];
#pragma unroll
    for (int ks = 0; ks < 16; ++ks) aq[ks] = *(const bf16x8*)(T.CQ + tok * 256 + ks * 16 + hi * 8);
    float rq, rk;
    { const f32x4 s0 = *(const f32x4*)(T.SSQ + tok * 8), s1 = *(const f32x4*)(T.SSQ + tok * 8 + 4);
      rq = rsqrtf(((s0[0] + s0[1]) + (s0[2] + s0[3])) * (1.0f / 256.0f) + EPS); rk = rsqrtf((s1[0] + s1[1]) * (1.0f / 128.0f) + EPS); }
    f32x4 cc[2], sn[2];
#pragma unroll
    for (int g = 0; g < 2; ++g) { cc[g] = *(const f32x4*)(T.CS + tok * 32 + 8 * g + 4 * hi); sn[g] = *(const f32x4*)(T.CS + tok * 32 + 16 + 8 * g + 4 * hi); }
    LAS float* gt = (LAS float*)(lds + GT);
    __syncthreads();
    if (tid < 160) gt[tid] = T.GN[GN_QN + tid];
    asm volatile("s_waitcnt vmcnt(0)" ::: "memory");
    __syncthreads();
    DMA_Q(0); DMA_Q(1);
    LAS unsigned char* stg = lds + STG + wid * 2048;
    const LAS unsigned char* wring = lds + jh * 2 * WSLOT;
    Packed pk0, pk1; bf16 *pd0 = nullptr, *pd1 = nullptr;
#pragma unroll 1
    for (int s = 0; s < 6; ++s) {
        if (s + 1 < 6) asm volatile("s_waitcnt vmcnt(8)" ::: "memory"); else asm volatile("s_waitcnt vmcnt(0)" ::: "memory");
        __builtin_amdgcn_s_barrier(); asm volatile("" ::: "memory");
        if (s > 0) { flush_tile(pk0, stg, pd0, 768, lane); flush_tile(pk1, stg, pd1, 768, lane); }
        const LAS unsigned char* wt = wring + (s & 1) * WSLOT;
        int swz_ = r32 & 15, r32_ = r32; asm volatile("" : "+v"(swz_), "+v"(r32_));
        f32x16 acc0 = f32x16{}, acc1 = f32x16{};
#pragma unroll
        for (int ks = 0; ks < 16; ++ks) { const int co = (((2 * ks + hi) ^ swz_) * 16);
            const bf16x8 w0 = *(const LAS bf16x8*)(wt + r32_ * 512 + co), w1 = *(const LAS bf16x8*)(wt + (r32_ + 32) * 512 + co);
            acc0 = MFMA32(w0, aq[ks], acc0); acc1 = MFMA32(w1, aq[ks], acc1); if ((ks & 3) == 3) __builtin_amdgcn_sched_barrier(0); }
        asm volatile("s_waitcnt lgkmcnt(0)" ::: "memory");
        __builtin_amdgcn_s_barrier(); asm volatile("" ::: "memory");
        const int j = 6 * jh + s;
        if (j < 8) {
            float ss = 0.f;
#pragma unroll
            for (int r = 0; r < 16; ++r) ss += acc0[r] * acc0[r] + acc1[r] * acc1[r];
            ss = half_swap_add(ss) * (rq * rq); const float rs = rsqrtf(ss * (1.0f / 64.0f) + EPS) * (SCALE_B * rq);
#pragma unroll
            for (int g = 0; g < 4; ++g) { const f32x4 g0 = *(const LAS f32x4*)(gt + GT_QN + 8 * g + 4 * hi) * rs, g1 = *(const LAS f32x4*)(gt + GT_QN + 32 + 8 * g + 4 * hi) * rs;
#pragma unroll
                for (int e = 0; e < 4; ++e) { acc0[4 * g + e] *= g0[e]; acc1[4 * g + e] *= g1[e]; } }
            pack_tile(pk0, acc0); pack_tile(pk1, acc1); pd0 = T.QB + tok0 * 768 + j * 96; pd1 = pd0 + 32;
        } else {
#pragma unroll
            for (int nt = 0; nt < 2; ++nt) { f32x16& a = nt ? acc1 : acc0; float ss = 0.f;
#pragma unroll
                for (int r = 0; r < 16; ++r) ss += a[r] * a[r];
                ss = half_swap_add(ss) * (rq * rq); const float rs = rsqrtf(ss * (1.0f / 32.0f) + EPS) * rq;
#pragma unroll
                for (int g = 0; g < 2; ++g) { const f32x4 g1 = *(const LAS f32x4*)(gt + GT_QR + 8 * g + 4 * hi) * rs, g2 = *(const LAS f32x4*)(gt + GT_QR + 16 + 8 * g + 4 * hi) * rs;
#pragma unroll
                    for (int e = 0; e < 4; ++e) { const float t1 = a[4 * g + e] * g1[e], t2 = a[8 + 4 * g + e] * g2[e];
                        a[4 * g + e] = (t1 * cc[g][e] - t2 * sn[g][e]) * SCALE_B; a[8 + 4 * g + e] = (t1 * sn[g][e] + t2 * cc[g][e]) * SCALE_B; } }
                if (nt == 0) { pack_tile(pk0, a); pd0 = T.QB + tok0 * 768 + (2 * (j - 8)) * 96 + 64; } else { pack_tile(pk1, a); pd1 = T.QB + tok0 * 768 + (2 * (j - 8) + 1) * 96 + 64; } }
        }
        if (s + 2 < 6) DMA_Q(s + 2);
    }
    bf16x8 ak[8];
#pragma unroll
    for (int ks = 0; ks < 8; ++ks) ak[ks] = *(const bf16x8*)(T.CKV + tok * 128 + ks * 16 + hi * 8);
    asm volatile("s_waitcnt vmcnt(0)" ::: "memory");
    __builtin_amdgcn_s_barrier(); asm volatile("" ::: "memory");
    DMA_KV(6); DMA_KV(7);
#pragma unroll 1
    for (int s = 6; s < 14; ++s) {
        if (s + 1 < 14) asm volatile("s_waitcnt vmcnt(4)" ::: "memory"); else asm volatile("s_waitcnt vmcnt(0)" ::: "memory");
        __builtin_amdgcn_s_barrier(); asm volatile("" ::: "memory");
        if (s == 6) { flush_tile(pk0, stg, pd0, 768, lane); flush_tile(pk1, stg, pd1, 768, lane); } else { flush_tile(pk0, stg, pd0, 512, lane); flush_tile(pk1, stg, pd1, 512, lane); }
        const LAS unsigned char* wt = wring + (s & 1) * WSLOT;
        int swz_ = r32 & 15, r32_ = r32; asm volatile("" : "+v"(swz_), "+v"(r32_));
        f32x16 acc0 = f32x16{}, acc1 = f32x16{};
#pragma unroll
        for (int ks = 0; ks < 8; ++ks) { const int co = (((2 * ks + hi) ^ swz_) * 16);
            const bf16x8 w0 = *(const LAS bf16x8*)(wt + r32_ * 256 + co), w1 = *(const LAS bf16x8*)(wt + (r32_ + 32) * 256 + co);
            acc0 = MFMA32(w0, ak[ks], acc0); acc1 = MFMA32(w1, ak[ks], acc1); if ((ks & 3) == 3) __builtin_amdgcn_sched_barrier(0); }
        asm volatile("s_waitcnt lgkmcnt(0)" ::: "memory");
        __builtin_amdgcn_s_barrier(); asm volatile("" ::: "memory");
        const int hd = s - 6;
        if (jh == 0) {
            float ss = 0.f;
#pragma unroll
            for (int r = 0; r < 16; ++r) ss += acc0[r] * acc0[r] + acc1[r] * acc1[r];
            ss = half_swap_add(ss) * (rk * rk); const float rs = rsqrtf(ss * (1.0f / 64.0f) + EPS) * rk;
#pragma unroll
            for (int g = 0; g < 4; ++g) { const f32x4 g0 = *(const LAS f32x4*)(gt + GT_KN + 8 * g + 4 * hi) * rs, g1 = *(const LAS f32x4*)(gt + GT_KN + 32 + 8 * g + 4 * hi) * rs;
#pragma unroll
                for (int e = 0; e < 4; ++e) { acc0[4 * g + e] *= g0[e]; acc1[4 * g + e] *= g1[e]; } }
        } else {
#pragma unroll
            for (int r = 0; r < 16; ++r) { acc0[r] *= rk; acc1[r] *= rk; }
        }
        pack_tile(pk0, acc0); pack_tile(pk1, acc1); pd0 = (jh == 0 ? T.KN : T.VB) + tok0 * 512 + hd * 64; pd1 = pd0 + 32;
        if (s + 2 < 14) DMA_KV(s + 2);
    }
    flush_tile(pk0, stg, pd0, 512, lane); flush_tile(pk1, stg, pd1, 512, lane);
#undef DMA_Q
#undef DMA_KV
}
}

struct Args { const void* in[18]; float* out; unsigned char* ws; int ph_lo, ph_hi, li, pad; };
constexpr int PER_PHASE = 6;
#ifndef MK_N_LAUNCHES
#define MK_N_LAUNCHES 1
#endif
constexpr int N_LAUNCHES = MK_N_LAUNCHES;

__global__ void __launch_bounds__(NWAVES * 64, 2) hybrid_fwd(Args args) {
    extern __shared__ __attribute__((aligned(16))) unsigned char lds[];
    Frame F;
    F.lds = (LAS unsigned char*)lds;
    F.MISC = (volatile LAS unsigned*)(F.lds + MISC_OFF);
    F.tid = threadIdx.x; F.lane = F.tid & 63; F.wave = __builtin_amdgcn_readfirstlane(F.tid >> 6);
    F.G = gridDim.x; { const int bx = blockIdx.x; F.vcu = (F.G % 8 == 0) ? (bx % 8) * (F.G / 8) + bx / 8 : bx; }
    unsigned char* const ws = args.ws;
    F.ctl = (gu32*)(ws + WS_CTL);
#define INF(i) ((const float*)args.in[i])
#define WSB(off) ((bf16*)(ws + (off)))
#define WSF(off) ((float*)(ws + (off)))
    for (int u = F.tid; u < (LDS_BYTES - LDSCTL_OFF) / 4; u += NWAVES * 64) ((LAS unsigned*)(F.lds + LDSCTL_OFF))[u] = 0u;
    __syncthreads();
    XcdBarrier bar; bar.bar = (unsigned*)(F.ctl + CW_BAR); bar.x = 0; bar.st = nullptr;
    if (N_LAUNCHES != PER_PHASE) bar = xcd_barrier_post((unsigned*)(F.ctl + CW_BAR), F.MISC + 8);
#define GRID_BAR() do { if (N_LAUNCHES == PER_PHASE) { if (F.tid == 0) __hip_atomic_store(F.ctl + CW_TMO, 0xBADBA0u, RLX_AGENT); } else { xcd_barrier(bar); } } while (0)
    const int lo = args.ph_lo, hi_ = args.ph_hi;
#define IN(k) (lo <= (k) && (k) < hi_)
#define BOTH(k) (IN(k) && IN((k) + 1))

    if (IN(0)) {
        ProIn P{INF(0), INF(2), INF(3), INF(4), INF(7), INF(8), INF(9), INF(10), INF(15), (const int*)args.in[1], WSB(WS_WIN), WSB(WS_WUQ), WSB(WS_WUKV), WSB(WS_WOUT), WSB(WS_XN), WSF(WS_CS), WSF(WS_BT), INF(5), INF(6), INF(11), INF(12), INF(13), INF(14), WSF(WS_GN)};
        p0_prologue(F, P); if (BOTH(0)) GRID_BAR(); }

    if (IN(1)) {
        pg8::Gemm g{WSB(WS_XN), WSB(WS_WIN), M, NIN, DMODEL}; pg8::StaticOrder S; S.init(M, NIN, F.G, (int)blockIdx.x);
        EpiP1 E{ws};
        pg8::gemm_phase<EpiP1, pg8::StaticOrder, true, true>(F.lds + RING_OFF, g, S, E);
        if (BOTH(1)) GRID_BAR();
    }
    if (IN(2)) {
        const p2c::T2 T{WSB(WS_CQ), WSB(WS_CKV), WSB(WS_WUQ), WSB(WS_WUKV), WSF(WS_SSQ), WSF(WS_GN), WSF(WS_CS), WSB(WS_QB), WSB(WS_KN), WSB(WS_VB)};
        for (int u = F.vcu; u < M / 128; u += F.G) p2c::unit(u, T, F.lds);
        __syncthreads();
        if (BOTH(2)) GRID_BAR();
    }
    if (IN(3)) {
        {
            const MlaT T{WSB(WS_QB), WSB(WS_KN), WSB(WS_KR), WSB(WS_VB), WSB(WS_SZ), WSB(WS_MIX)};
            for (int uidx = F.vcu; uidx < 1024; uidx += F.G) {
                int bh, qb;
                if (F.G == 256) { const int r = uidx >> 8, x = F.vcu >> 5, i = F.vcu & 31, c16 = i & 15; bh = 8 * x + 2 * r + (i >> 4); qb = (r & 1) ? 15 - c16 : c16; }
                else { bh = uidx >> 4; qb = uidx & 15; }
                mla2::unit(bh >> 3, bh & 7, qb, T, (char*)lds);
            }
        }
        __syncthreads();
        {
            const dil4::T4 T4{WSB(WS_QA), WSB(WS_KA), WSB(WS_VA), WSB(WS_OP0), WSB(WS_OP1), WSB(WS_OP2), WSF(WS_LP), WSF(WS_BT)};
            const float* BT = WSF(WS_BT);
            const bool loc = (F.G == 256); const int x = F.vcu >> 5, i = F.vcu & 31;
            int cur_h = -1; int slot = 0; unsigned occ = 0;
            const int nrounds = loc ? 3 : (768 + F.G - 1) / F.G;
#pragma unroll 1
            for (int n = 0; n < nrounds; ++n) {
                int bh, rr;
                if (loc) { const int idx = n * 32 + i, bsel = idx / 12; rr = idx - 12 * bsel; bh = 8 * bsel + x; }
                else { const int u = n * F.G + F.vcu; bh = u / 12; rr = u % 12; if (u >= 768) bh = -1; }
                const int h_ = bh & 7;
                if (h_ != cur_h || !loc) { __syncthreads(); if (bh >= 0) dil4::build_tables(BT, h_, F.lds); __syncthreads(); cur_h = h_; }
                if (bh >= 0) { const int p_ = rr >> 2, q_ = rr & 3;
                    if (p_ == 0) dil6::run<1, 0>(bh, 0, 1024 * q_, slot, occ, T4, F.lds); else if (p_ == 1) dil6::run<4, 1>(bh, q_, 0, slot, occ, T4, F.lds); else dil6::run<16, 2>(bh, 4 * q_, 0, slot, occ, T4, F.lds); }
            }
        }
        if (BOTH(3)) GRID_BAR();
    }
    if (IN(4)) {
        const bf16 *OP0 = WSB(WS_OP0), *OP1 = WSB(WS_OP1), *OP2 = WSB(WS_OP2), *SZ = WSB(WS_SZ); bf16* MIX = WSB(WS_MIX); const float* LP = WSF(WS_LP);
        const int gt = F.vcu * (NWAVES * 64) + F.tid, NGT = F.G * NWAVES * 64;
        for (int e = gt; e < M * 64; e += NGT) { const int row = e >> 6, c8 = (e & 63) * 8, h = c8 >> 6;
            const size_t off = (size_t)row * 512 + c8;
            const v4u a = *(const v4u*)(OP0 + off), b2 = *(const v4u*)(OP1 + off), c = *(const v4u*)(OP2 + off), z = *(const v4u*)(SZ + (size_t)row * 1024 + c8);
            const float lt = LP[((size_t)0 * M + row) * 8 + h] + LP[((size_t)1 * M + row) * 8 + h] + LP[((size_t)2 * M + row) * 8 + h]; const float rl = 1.0f / lt;
            v4u o;
#pragma unroll
            for (int k = 0; k < 4; ++k) { const float lo_ = (bflo(a[k]) + bflo(b2[k]) + bflo(c[k])) * rl * bflo(z[k]), hi2 = (bfhi(a[k]) + bfhi(b2[k]) + bfhi(c[k])) * rl * bfhi(z[k]); o[k] = pk2(lo_, hi2); }
            *(v4u*)(MIX + (size_t)row * 1024 + c8) = o; }
        if (BOTH(4)) GRID_BAR();
    }
    if (IN(5)) {
        pg8::Gemm g{WSB(WS_MIX), WSB(WS_WOUT), M, DMODEL, DMODEL}; pg8::StaticOrder S; S.init(M, DMODEL, F.G, (int)blockIdx.x);
        EpiOut E{INF(0), args.out};
        pg8::gemm_phase<EpiOut, pg8::StaticOrder, true, true>(F.lds + RING_OFF, g, S, E);
    }
#undef IN
#undef BOTH
}

extern "C" void kernel_launch(void* const* d_in, const int* in_sizes, int n_in, void* d_out, int out_size, void* d_ws, size_t ws_size, hipStream_t stream) {
    static int grid = 0;
    if (grid == 0) {
        if (n_in != 16 || in_sizes[0] != M * DMODEL || out_size != M * DMODEL || ws_size < WS_END) { fprintf(stderr, "kernel_launch: unexpected shapes (n_in %d, in0 %d, out %d, ws %zu)\n", n_in, n_in > 0 ? in_sizes[0] : -1, out_size, ws_size); grid = -1; return; }
        int dev = 0, cus = 0, per_cu = 0;
        if (hipGetDevice(&dev) != hipSuccess || hipDeviceGetAttribute(&cus, hipDeviceAttributeMultiprocessorCount, dev) != hipSuccess) { grid = -1; return; }
        if (hipFuncSetAttribute((const void*)hybrid_fwd, hipFuncAttributeMaxDynamicSharedMemorySize, LDS_BYTES) != hipSuccess) { fprintf(stderr, "kernel_launch: hipFuncSetAttribute failed\n"); grid = -1; return; }
        if (hipOccupancyMaxActiveBlocksPerMultiprocessor(&per_cu, (const void*)hybrid_fwd, NWAVES * 64, LDS_BYTES) != hipSuccess || per_cu < 1) { fprintf(stderr, "kernel_launch: occupancy query says %d blocks per CU\n", per_cu); (void)hipGetLastError(); grid = -1; return; }
        grid = cus;
    }
    if (grid < 0) return;
    (void)hipMemsetAsync((char*)d_ws + WS_CTL, 0, CTL_ZERO_BYTES, stream);
    Args a{};
    for (int i = 0; i < 16; ++i) a.in[i] = d_in[i];
    a.out = (float*)d_out; a.ws = (unsigned char*)d_ws;
    for (int li = 0; li < N_LAUNCHES; ++li) {
        if (N_LAUNCHES == PER_PHASE) { a.ph_lo = li; a.ph_hi = li + 1; } else { a.ph_lo = 0; a.ph_hi = PER_PHASE; }
        a.li = li;
        hipLaunchKernelGGL(hybrid_fwd, dim3(grid), dim3(NWAVES * 64), LDS_BYTES, stream, a);
    }
}
```

```cpp
#include <hip/hip_runtime.h>
#include <cstdio>
#include <cstdint>
#include <cmath>
namespace pg8 {
#define PG8_LAS __attribute__((address_space(3)))
typedef unsigned short bf16_t;
typedef short bf16x8 __attribute__((ext_vector_type(8)));
typedef float f32x4 __attribute__((ext_vector_type(4)));
typedef unsigned u32x4 __attribute__((ext_vector_type(4)));
constexpr int BM = 256, BK = 64, HALF = 128, HTB = HALF * BK * 2  , STAGE_BYTES = 8 * HTB, NXCD = 8, WGM = 8;

__host__ __device__ __forceinline__ int lds_byte(int r, int c) { const int st = (r >> 4) * 2 + (c >> 5), rr = r & 15, cc = c & 31, ob = rr * 64 + cc * 2; return st * 1024 + (ob ^ (((ob >> 9) & 1) << 5)); }
__host__ __device__ __forceinline__ void stage_rc(int b, int& R, int& C) { const int st = b / 1024, sb = b % 1024, swz = sb ^ (((sb >> 9) & 1) << 5); R = (st >> 1) * 16 + swz / 64; C = (st & 1) * 32 + (swz % 64) / 2; }
__host__ __device__ __forceinline__ int perm32(int rho) { const int n = rho >> 4, i = rho & 15; return 8 * (i >> 2) + 4 * n + (i & 3); }

struct Unit { int pm, pn; };
struct Gemm { const bf16_t* A; const bf16_t* Bt; int M, N, K; };

struct StaticOrder {
    int nM, nN, nwg, G, c;
    __host__ __device__ void init(int M, int N, int G_, int c_) { nM = M / BM; nN = N / BM; nwg = nM * nN; G = G_; c = c_; }
    __host__ __device__ bool next(int i, Unit& u) const {
        const long L = (long)i * G + c; if (L >= nwg) return false;
        int wgid = (int)L; { const int q = nwg / NXCD, r = nwg % NXCD, xcd = wgid % NXCD, off = wgid / NXCD; wgid = (xcd < r ? xcd * (q + 1) : r * (q + 1) + (xcd - r) * q) + off; }
        const int nig = WGM * nN, gid = wgid / nig, fm = gid * WGM, gsz = (nM - fm) < WGM ? (nM - fm) : WGM;
        u.pm = fm + ((wgid % nig) % gsz); u.pn = (wgid % nig) / gsz; return true;
    }
    __device__ __forceinline__ void a_ready(const Unit&) const {}
    __device__ __forceinline__ void done(const Unit&) const {}
};


template <class Epi, class Sched, bool ALIGN_EPI = false, bool SP2 = false>
__device__ __forceinline__ void gemm_phase(PG8_LAS unsigned char* lds, const Gemm g, const Sched& S, const Epi& E) {
    int tid_ = threadIdx.x; asm volatile("" : "+v"(tid_));
    const int tid = tid_, wid = __builtin_amdgcn_readfirstlane(tid >> 6), lane = tid & 63, wr = wid >> 2, wc = wid & 3, fr = lane & 15, fq = lane >> 4;
    const int K = g.K, nt = K / BK;
    unsigned voffA[2], voffB[2];
#pragma unroll
    for (int i = 0; i < 2; ++i) { int R, C; stage_rc(tid * 16 + i * 8192, R, C); const int Rb = Epi::PERM ? ((R & ~31) + perm32(R & 31)) : R;
        voffA[i] = (unsigned)(R * K + C) * 2u; voffB[i] = (unsigned)(Rb * K + C) * 2u; }
    const size_t kstep = (size_t)(BK * 2);
    const size_t hstep = (size_t)HALF * K * 2;
    const size_t tstep = 2 * hstep;
    const unsigned ldsw = (unsigned)wid * 1024u;
    const int aoff = lds_byte(wr * 64 + fr, fq * 8), boff = lds_byte(wc * 32 + fr, fq * 8);
#define PG8_SA(b, h) (((b) * 2 + (h)) * HTB)
#define PG8_SB(b, h) ((4 + (b) * 2 + (h)) * HTB)
#define PG8_STAGE(bufoff, gbase, voff) do { _Pragma("unroll") for (int _i = 0; _i < 2; ++_i) \
        __builtin_amdgcn_global_load_lds((const unsigned*)((const char*)(gbase) + (voff)[_i]), (PG8_LAS unsigned*)(lds + (bufoff) + ldsw + _i * 8192), 16, 0, 0); } while (0)
#define PG8_LDA(dst, b, h) do { _Pragma("unroll") for (int m = 0; m < 4; ++m) _Pragma("unroll") for (int k = 0; k < 2; ++k) dst[m][k] = *(const PG8_LAS bf16x8*)(lds + PG8_SA(b, h) + aoff + m * 2048 + k * 1024); } while (0)
#define PG8_LDB(dst, b, h) do { _Pragma("unroll") for (int n = 0; n < 2; ++n) _Pragma("unroll") for (int k = 0; k < 2; ++k) dst[n][k] = *(const PG8_LAS bf16x8*)(lds + PG8_SB(b, h) + boff + n * 2048 + k * 1024); } while (0)
#define PG8_MMA(ai, bj, At, Bt) do { __builtin_amdgcn_s_setprio(1); _Pragma("unroll") for (int m = 0; m < 4; ++m) _Pragma("unroll") for (int n = 0; n < 2; ++n) _Pragma("unroll") for (int k = 0; k < 2; ++k) \
        acc[ai][bj][m][n] = __builtin_amdgcn_mfma_f32_16x16x32_bf16(Bt[n][k], At[m][k], acc[ai][bj][m][n], 0, 0, 0); __builtin_amdgcn_s_setprio(0); } while (0)
#define PG8_WAIT_V(n) asm volatile("s_waitcnt vmcnt(" #n ")" ::: "memory")
#define PG8_WAIT_L(n) asm volatile("s_waitcnt lgkmcnt(" #n ")" ::: "memory")
#define PG8_BAR __builtin_amdgcn_s_barrier()
#define PG8_SCHED __builtin_amdgcn_sched_barrier(0)
    Unit cur, nxt; int ui = 0;
    if (!S.next(0, cur)) return;
    f32x4 acc[2][2][4][2];
#pragma unroll
    for (int a = 0; a < 2; ++a)
#pragma unroll
        for (int b = 0; b < 2; ++b)
#pragma unroll
            for (int m = 0; m < 4; ++m)
#pragma unroll
                for (int n = 0; n < 2; ++n) acc[a][b][m][n] = (f32x4){0.f, 0.f, 0.f, 0.f};
    if constexpr (Epi::INIT) E.init(acc, cur, wr, wc, fr, fq);
    bf16x8 At[4][2], B0[2][2], B1[2][2];
    const char* cA = (const char*)g.A + (size_t)cur.pm * tstep; const char* cB = (const char*)g.Bt + (size_t)cur.pn * tstep;
    S.a_ready(cur);
    if constexpr (SP2) {
        PG8_STAGE(PG8_SB(0, 0), cB, voffB); PG8_STAGE(PG8_SB(0, 1), cB + hstep, voffB); PG8_STAGE(PG8_SA(0, 0), cA, voffA); PG8_STAGE(PG8_SA(0, 1), cA + hstep, voffA);
        if (wr == 1) PG8_BAR;
        PG8_WAIT_V(2); PG8_BAR;
        PG8_STAGE(PG8_SB(1, 0), cB + kstep, voffB); PG8_STAGE(PG8_SA(1, 0), cA + kstep, voffA); PG8_STAGE(PG8_SB(1, 1), cB + hstep + kstep, voffB);
        PG8_WAIT_V(6); PG8_BAR;
    } else {
        PG8_STAGE(PG8_SB(0, 0), cB, voffB); PG8_STAGE(PG8_SA(0, 0), cA, voffA); PG8_STAGE(PG8_SB(0, 1), cB + hstep, voffB); PG8_STAGE(PG8_SA(0, 1), cA + hstep, voffA);
        if (wr == 1) PG8_BAR;
        PG8_WAIT_V(4); PG8_BAR;
        PG8_STAGE(PG8_SB(1, 0), cB + kstep, voffB); PG8_STAGE(PG8_SA(1, 0), cA + kstep, voffA); PG8_STAGE(PG8_SB(1, 1), cB + hstep + kstep, voffB);
        PG8_WAIT_V(6); PG8_BAR;
    }
    for (;;) {
        const bool has_next = S.next(ui + 1, nxt);
        const char* nA = has_next ? (const char*)g.A + (size_t)nxt.pm * tstep : cA; const char* nB = has_next ? (const char*)g.Bt + (size_t)nxt.pn * tstep : cB;
        for (int t = 0; t < nt; t += 2) {
            const bool last = (t == nt - 2);
            const char* a1 = cA + (size_t)(t + 1) * kstep;
            const char* a2 = last ? nA : cA + (size_t)(t + 2) * kstep; const char* b2 = last ? nB : cB + (size_t)(t + 2) * kstep;
            const char* a3 = a2 + kstep; const char* b3 = b2 + kstep;
            if (last && has_next) S.a_ready(nxt);
            if constexpr (SP2) {
            PG8_LDB(B0, 0, 0); PG8_LDB(B1, 0, 1); PG8_SCHED; PG8_LDA(At, 0, 0); PG8_STAGE(PG8_SA(1, 1), a1 + hstep, voffA);
            PG8_WAIT_V(8); PG8_WAIT_L(0); PG8_BAR; PG8_MMA(0, 0, At, B0); PG8_MMA(0, 1, At, B1); PG8_BAR; PG8_SCHED;
            PG8_LDA(At, 0, 1); PG8_STAGE(PG8_SB(0, 0), b2, voffB); PG8_STAGE(PG8_SB(0, 1), b2 + hstep, voffB); PG8_STAGE(PG8_SA(0, 0), a2, voffA);
            PG8_WAIT_V(8); PG8_WAIT_L(0); PG8_BAR; PG8_MMA(1, 0, At, B0); PG8_MMA(1, 1, At, B1); PG8_BAR; PG8_SCHED;
            PG8_LDB(B0, 1, 0); PG8_LDB(B1, 1, 1); PG8_SCHED; PG8_LDA(At, 1, 0); PG8_STAGE(PG8_SA(0, 1), a2 + hstep, voffA);
            PG8_WAIT_V(8); PG8_WAIT_L(0); PG8_BAR; PG8_MMA(0, 0, At, B0); PG8_MMA(0, 1, At, B1); PG8_BAR; PG8_SCHED;
            PG8_LDA(At, 1, 1); PG8_STAGE(PG8_SB(1, 0), b3, voffB); PG8_STAGE(PG8_SB(1, 1), b3 + hstep, voffB); PG8_STAGE(PG8_SA(1, 0), a3, voffA);
            PG8_WAIT_V(8); PG8_WAIT_L(0); PG8_BAR; PG8_MMA(1, 0, At, B0); PG8_MMA(1, 1, At, B1); PG8_BAR; PG8_SCHED;
            } else {
            PG8_LDB(B0, 0, 0); PG8_SCHED; PG8_LDA(At, 0, 0); PG8_STAGE(PG8_SA(1, 1), a1 + hstep, voffA);
            PG8_WAIT_L(8); PG8_BAR; PG8_WAIT_L(0); PG8_MMA(0, 0, At, B0); PG8_BAR; PG8_SCHED;
            PG8_LDB(B1, 0, 1); PG8_STAGE(PG8_SB(0, 0), b2, voffB);
            PG8_BAR; PG8_WAIT_L(0); PG8_MMA(0, 1, At, B1); PG8_BAR;
            PG8_LDA(At, 0, 1); PG8_STAGE(PG8_SA(0, 0), a2, voffA);
            PG8_BAR; PG8_WAIT_L(0); PG8_MMA(1, 0, At, B0); PG8_BAR; PG8_SCHED;
            PG8_STAGE(PG8_SB(0, 1), b2 + hstep, voffB);
            PG8_WAIT_V(6); PG8_BAR; PG8_MMA(1, 1, At, B1); PG8_BAR;
            PG8_LDB(B0, 1, 0); PG8_SCHED; PG8_LDA(At, 1, 0); PG8_STAGE(PG8_SA(0, 1), a2 + hstep, voffA);
            PG8_WAIT_L(8); PG8_BAR; PG8_WAIT_L(0); PG8_MMA(0, 0, At, B0); PG8_BAR; PG8_SCHED;
            PG8_LDB(B1, 1, 1); PG8_STAGE(PG8_SB(1, 0), b3, voffB);
            PG8_BAR; PG8_WAIT_L(0); PG8_MMA(0, 1, At, B1); PG8_BAR;
            PG8_LDA(At, 1, 1); PG8_STAGE(PG8_SA(1, 0), a3, voffA);
            PG8_BAR; PG8_WAIT_L(0); PG8_MMA(1, 0, At, B0); PG8_BAR; PG8_SCHED;
            PG8_STAGE(PG8_SB(1, 1), b3 + hstep, voffB);
            PG8_WAIT_V(6); PG8_BAR; PG8_MMA(1, 1, At, B1); PG8_BAR;
            }
        }
        if constexpr (ALIGN_EPI) { if (wr == 0) PG8_BAR; }
        if constexpr (!Epi::AFTER_DRAIN) { E(acc, cur, wr, wc, fr, fq); S.done(cur); }
        if (!has_next) break;
#pragma unroll
        for (int a = 0; a < 2; ++a)
#pragma unroll
            for (int b = 0; b < 2; ++b)
#pragma unroll
                for (int m = 0; m < 4; ++m)
#pragma unroll
                    for (int n = 0; n < 2; ++n) acc[a][b][m][n] = (f32x4){0.f, 0.f, 0.f, 0.f};
        if constexpr (Epi::INIT) E.init(acc, nxt, wr, wc, fr, fq);
        cur = nxt; cA = nA; cB = nB; ++ui;
        if constexpr (ALIGN_EPI) { if (wr == 1) PG8_BAR; }
    }
    PG8_WAIT_V(0);
    if constexpr (!ALIGN_EPI) { if (wr == 0) PG8_BAR; }
    PG8_BAR;
    if constexpr (Epi::AFTER_DRAIN) { E.fused(acc, cur, wr, wc, fr, fq, lds, wid, lane); S.done(cur); }
#undef PG8_SA
#undef PG8_SB
#undef PG8_STAGE
#undef PG8_LDA
#undef PG8_LDB
#undef PG8_MMA
#undef PG8_WAIT_V
#undef PG8_WAIT_L
#undef PG8_BAR
#undef PG8_SCHED
}
}

constexpr int BATCH = 8, SEQ = 4096, DMODEL = 1024, M = BATCH * SEQ;
constexpr int NIN = 3072;
constexpr int QLR = 256, KVLR = 128, DQK = 96;
constexpr float EPS = 1e-6f, LOG2E = 1.4426950408889634f;
constexpr float SCALE_A = 0.125f * LOG2E;
constexpr float SCALE_B = 0.10206207261596577f * LOG2E;
constexpr int NWAVES = 8;

constexpr size_t MiB = 1u << 20;
constexpr size_t WS_CTL = 0, CTL_ZERO_BYTES = 1 * MiB;
constexpr size_t WS_WIN = 2 * MiB, WS_WUQ = 8 * MiB, WS_WUKV = 9 * MiB, WS_WOUT = 10 * MiB;
constexpr size_t WS_CS = 12 * MiB;
constexpr size_t WS_BT = 16 * MiB;
constexpr size_t WS_GN = 16 * MiB + 65536;
constexpr int GN_AQ = 0, GN_AK = 64, GN_QN = 128, GN_QR = 192, GN_KN = 224, GN_KR = 288;
constexpr size_t WS_SSQ = 17 * MiB;
constexpr size_t WS_LP = 18 * MiB;
constexpr size_t WS_KR = 22 * MiB;
constexpr size_t WS_XN = 24 * MiB;
constexpr size_t WS_CQ = 88 * MiB;
constexpr size_t WS_CKV = 104 * MiB;
constexpr size_t WS_QA = 112 * MiB, WS_KA = 144 * MiB, WS_VA = 176 * MiB;
constexpr size_t WS_SZ = 208 * MiB;
constexpr size_t WS_QB = 272 * MiB;
constexpr size_t WS_KN = 320 * MiB, WS_VB = 352 * MiB;
constexpr size_t WS_MIX = 384 * MiB;
constexpr size_t WS_OP0 = 24 * MiB, WS_OP1 = 56 * MiB, WS_OP2 = 448 * MiB;
constexpr size_t WS_END = 480 * MiB;

constexpr int CW_TMO = 0, CW_BAR = 4096;

constexpr int RING_OFF = 0, RING_BYTES = 131072;
constexpr int LDSCTL_OFF = RING_BYTES, MISC_OFF = LDSCTL_OFF + 320;
constexpr int LDS_BYTES = 163840;

#define GAS __attribute__((address_space(1)))
#define LAS __attribute__((address_space(3)))
typedef unsigned short bf16;
typedef unsigned v4u __attribute__((ext_vector_type(4)));
typedef float f32x4 __attribute__((ext_vector_type(4)));
typedef float f32x16 __attribute__((ext_vector_type(16)));
typedef short bf16x8 __attribute__((ext_vector_type(8)));
typedef short s16x4 __attribute__((ext_vector_type(4)));
typedef GAS unsigned gu32;
#define RLX_AGENT __ATOMIC_RELAXED, __HIP_MEMORY_SCOPE_AGENT
#define LDS_WAIT() asm volatile("s_waitcnt lgkmcnt(0)" ::: "memory")
#define VM_WAIT() asm volatile("s_waitcnt vmcnt(0)" ::: "memory")
typedef float f32x2_t __attribute__((ext_vector_type(2))); typedef __bf16 bf16x2_t __attribute__((ext_vector_type(2)));
__device__ __forceinline__ unsigned pk2(float lo, float hi) { f32x2_t v = {lo, hi}; bf16x2_t b = __builtin_convertvector(v, bf16x2_t); return __builtin_bit_cast(unsigned, b); }
__device__ __forceinline__ float bf2f(unsigned short b) { return __uint_as_float((unsigned)b << 16); }
__device__ __forceinline__ float bflo(unsigned w) { return __uint_as_float(w << 16); }
__device__ __forceinline__ float bfhi(unsigned w) { return __uint_as_float(w & 0xffff0000u); }
__device__ __forceinline__ int crow(int r, int hi) { return (r & 3) + 8 * (r >> 2) + 4 * hi; }

#define XB_TMO      128
#define XB_XCNT(j)  (256  + 64 * (j))
#define XB_XSUB(j)  (1280 + 64 * (j))
#define XB_XGEN(j)  (2304 + 64 * (j))
#define XB_TOP      3328
#define XB_TOPGEN   3392
#define XCD_BAR_WORDS 3456
#define XB_SPIN_CAP (1u << 18)

__device__ __forceinline__ unsigned xb_ld(unsigned* p)              { return __hip_atomic_load(p, __ATOMIC_RELAXED, __HIP_MEMORY_SCOPE_AGENT); }
__device__ __forceinline__ unsigned xb_add(unsigned* p, unsigned v) { return __hip_atomic_fetch_add(p, v, __ATOMIC_RELAXED, __HIP_MEMORY_SCOPE_AGENT); }
__device__ __forceinline__ unsigned xb_xcc_id() { return (unsigned)__builtin_amdgcn_s_getreg((3 << 11) | 20) & 0xFu; }
#define XB_SPIN(cond, bar) do { unsigned _sp = 0; while (cond) { __builtin_amdgcn_s_sleep(1); \
    if ((++_sp & 255u) == 0u) { if (xb_ld(&(bar)[XB_TMO])) break; if (_sp > XB_SPIN_CAP) { atomicAdd(&(bar)[XB_TMO], 1u); break; } } } } while (0)

struct XcdBarrier {
    unsigned* bar; unsigned x;
    volatile LAS unsigned* st;
};

__device__ __forceinline__ XcdBarrier xcd_barrier_post(unsigned* bar, volatile LAS unsigned* st) {
    XcdBarrier b; b.bar = bar; b.x = xb_xcc_id(); b.st = st;
    if (threadIdx.x == 0) (void)xb_add(&bar[XB_XCNT(b.x)], 1u);
    return b;
}
__device__ __forceinline__ void xcd_barrier_complete(unsigned* bar, unsigned x, unsigned& nloc, unsigned& nx) {
    const unsigned G = gridDim.x * gridDim.y * gridDim.z;
    unsigned sum, cnt, mine, sp = 0u;
    for (;;) {
        sum = 0u; cnt = 0u; mine = 0u;
#pragma unroll
        for (unsigned j = 0; j < 16; ++j) { const unsigned c = xb_ld(&bar[XB_XCNT(j)]); sum += c; cnt += (c > 0u) ? 1u : 0u; mine = (j == x) ? c : mine; }
        if (sum == G) break;
        __builtin_amdgcn_s_sleep(1);
        if ((++sp & 255u) == 0u) { if (xb_ld(&bar[XB_TMO])) break; if (sp > XB_SPIN_CAP) { atomicAdd(&bar[XB_TMO], 1u); break; } }
    }
    nloc = mine > 0u ? mine : 1u; nx = cnt > 0u ? cnt : 1u;
}

__device__ __forceinline__ void xcd_barrier(const XcdBarrier& b) {
    asm volatile("s_waitcnt vmcnt(0)" ::: "memory");
    __syncthreads();
    if (threadIdx.x == 0) {
        unsigned* bar = b.bar;
        __builtin_amdgcn_s_waitcnt(0);
        unsigned nloc = b.st[0], nx = b.st[1];
        if (nloc == 0u) { xcd_barrier_complete(bar, b.x, nloc, nx); b.st[0] = nloc; b.st[1] = nx; }
        const unsigned old = xb_add(&bar[XB_XSUB(b.x)], 1u);
        const unsigned gen = old / nloc;
        if (old + 1u == (gen + 1u) * nloc) {
            __builtin_amdgcn_fence(__ATOMIC_RELEASE, "agent");
            asm volatile("s_waitcnt vmcnt(0)" ::: "memory");
            const unsigned og = xb_add(&bar[XB_TOP], 1u);
            const unsigned tg = og / nx;
            if (og + 1u == (tg + 1u) * nx) xb_add(&bar[XB_TOPGEN], 1u);
            else XB_SPIN(xb_ld(&bar[XB_TOPGEN]) == tg, bar);
            __builtin_amdgcn_fence(__ATOMIC_ACQUIRE, "agent");
            xb_add(&bar[XB_XGEN(b.x)], 1u);
            asm volatile("s_waitcnt vmcnt(0)" ::: "memory");
        } else {
            XB_SPIN(xb_ld(&bar[XB_XGEN(b.x)]) == gen, bar);
            __builtin_amdgcn_fence(__ATOMIC_ACQUIRE, "agent");
            asm volatile("s_waitcnt vmcnt(0)" ::: "memory");
        }
    }
    __syncthreads();
}


struct Frame {
    LAS unsigned char* lds;
    volatile LAS unsigned* MISC;
    gu32* ctl;
    int tid, lane, wave, vcu, G;
};
struct ProIn { const float *x, *rel_bias, *norm_gain, *w_in, *qc_gain, *w_uq, *kvc_gain, *w_ukv, *w_out; const int* positions; bf16 *WinT, *WuqT, *WukvT, *WoutT, *XN; float *CS, *BT; const float *aq, *ak, *qn, *qr, *kn, *kr; float* GN; };
struct MlaT { const bf16 *QB, *KN, *KR, *VB, *SZ; bf16* MIX; };

__device__ __forceinline__ float wave_sum(float v) {
#pragma unroll
    for (int o = 1; o < 64; o <<= 1) v += __shfl_xor(v, o);
    return v;
}
__device__ __forceinline__ void wprep_item(const float* W, int ldw, int src0, bf16* WT, int K, int dst_row0, const float* gk, LAS float* scr, int kb, int lane) {
    const int k0 = 64 * kb;
    if (src0 < 0) {
#pragma unroll
        for (int j = 0; j < 4; ++j) { const int n = (lane >> 3) + 8 * j; *(GAS v4u*)(WT + (size_t)(dst_row0 + n) * K + k0 + 8 * (lane & 7)) = (v4u){0u, 0u, 0u, 0u}; }
        return;
    }
#pragma unroll 8
    for (int i = 0; i < 32; ++i) { const int kk = 2 * i + (lane >> 5); const float g = gk ? gk[k0 + kk] : 1.0f; scr[kk * 33 + (lane & 31)] = W[(size_t)(k0 + kk) * ldw + src0 + (lane & 31)] * g; }
    LDS_WAIT(); asm volatile("" ::: "memory");
    const int c = lane & 7;
#pragma unroll
    for (int j = 0; j < 4; ++j) { const int n = (lane >> 3) + 8 * j; const LAS float* s = scr + (8 * c) * 33 + n;
        v4u o; o.x = pk2(s[0 * 33], s[1 * 33]); o.y = pk2(s[2 * 33], s[3 * 33]); o.z = pk2(s[4 * 33], s[5 * 33]); o.w = pk2(s[6 * 33], s[7 * 33]);
        *(GAS v4u*)(WT + (size_t)(dst_row0 + n) * K + k0 + 8 * c) = o; }
    LDS_WAIT(); asm volatile("" ::: "memory");
}
__device__ __forceinline__ int win_src(int db) {
    const int pn = db >> 3, p0 = (db & 7) * 32, bj = p0 >> 7, wc = (p0 & 127) >> 5;
    if (pn < 10) { const int seg = pn >> 1, T = pn & 1, head = 4 * T + wc; const int base = seg == 0 ? 0 : seg == 1 ? 512 : seg == 2 ? 1024 : seg == 3 ? 1536 : 2464; return base + head * 64 + 32 * bj; }
    if (pn == 10) return 2048 + 64 * wc + 32 * bj;
    if (wc < 2) return 2304 + 64 * wc + 32 * bj;
    if (wc == 2 && bj == 0) return 2432;
    return -1;
}
__device__ __forceinline__ int wuq_src(int db) { const int job = db >> 1, nh = db & 1; return job < 8 ? job * 96 + 32 * nh : (2 * (job - 8) + nh) * 96 + 64; }
__device__ __forceinline__ int wukv_src(int db) { const int job = db >> 1, nh = db & 1; return job < 8 ? job * 128 + 32 * nh : (job - 8) * 128 + 64 + 32 * nh; }
__device__ __forceinline__ int t5_bucket(int dist) {
    if (dist < 16) return dist;
    const float d = (float)dist;
    int large = 16 + (int)(logf(d / 16.0f) / 4.852030263919617f * 16.0f);
    return large < 31 ? large : 31;
}
__device__ __forceinline__ void sincos_rev(double f, float& s, float& c) {
    const double k = rint(4.0 * f); const double y = (f - 0.25 * k) * 6.283185307179586476925287;
    const double y2 = y * y;
    const double sy = y * (1.0 + y2 * (-1.0 / 6 + y2 * (1.0 / 120 + y2 * (-1.0 / 5040 + y2 * (1.0 / 362880 + y2 * (-1.0 / 39916800 + y2 * (1.0 / 6227020800.0)))))));
    const double cy = 1.0 + y2 * (-0.5 + y2 * (1.0 / 24 + y2 * (-1.0 / 720 + y2 * (1.0 / 40320 + y2 * (-1.0 / 3628800 + y2 * (1.0 / 479001600.0 + y2 * (-1.0 / 87178291200.0)))))));
    const int q = ((int)k) & 3;
    const double ss = (q == 0) ? sy : (q == 1) ? cy : (q == 2) ? -sy : -cy;
    const double cc = (q == 0) ? cy : (q == 1) ? -sy : (q == 2) ? -cy : sy;
    s = (float)ss; c = (float)cc;
}
__device__ __forceinline__ float inv_freq(int i) {
    const int e = i >> 2, r = i & 3;
    const double m = r == 0 ? 1.0 : r == 1 ? 0.5623413251903491 : r == 2 ? 0.31622776601683794 : 0.1778279410038923;
    const double p = e == 0 ? 1.0 : e == 1 ? 0.1 : e == 2 ? 0.01 : 0.001;
    return (float)(m * p);
}
__device__ __forceinline__ void p0_prologue(const Frame& F, const ProIn P) {
    LAS float* scr = (LAS float*)(F.lds + RING_OFF + F.wave * 16384);
    const int gw = F.vcu * NWAVES + F.wave, NGW = F.G * NWAVES;
    constexpr int I_IN = (NIN / 32) * (DMODEL / 64), I_UQ = (768 / 32) * (QLR / 64), I_UKV = (1024 / 32) * (KVLR / 64), I_OUT = (1024 / 32) * (1024 / 64);
    constexpr int NITEMS = I_IN + I_UQ + I_UKV + I_OUT;
    for (int it = gw; it < NITEMS; it += NGW) {
        int r = it;
        if (r < I_IN) { const int db = r / 16, kb = r % 16; wprep_item(P.w_in, 2976, win_src(db), P.WinT, DMODEL, 32 * db, nullptr, scr, kb, F.lane); continue; } r -= I_IN;
        if (r < I_UQ) { const int db = r / 4, kb = r % 4; wprep_item(P.w_uq, 768, wuq_src(db), P.WuqT, QLR, 32 * db, P.qc_gain, scr, kb, F.lane); continue; } r -= I_UQ;
        if (r < I_UKV) { const int db = r / 2, kb = r % 2; wprep_item(P.w_ukv, 1024, wukv_src(db), P.WukvT, KVLR, 32 * db, P.kvc_gain, scr, kb, F.lane); continue; } r -= I_UKV;
        { const int db = r / 16, kb = r % 16; wprep_item(P.w_out, 1024, 32 * db, P.WoutT, 1024, 32 * db, nullptr, scr, kb, F.lane); }
    }
    if (F.vcu == 0 && F.tid < 64) { const int t = F.tid; P.GN[GN_AQ + t] = P.aq[t]; P.GN[GN_AK + t] = P.ak[t]; P.GN[GN_QN + t] = P.qn[t]; P.GN[GN_KN + t] = P.kn[t]; if (t < 32) { P.GN[GN_QR + t] = P.qr[t]; P.GN[GN_KR + t] = P.kr[t]; } }
    { f32x4 g[4];
#pragma unroll
      for (int j = 0; j < 4; ++j) g[j] = *((const GAS f32x4*)P.norm_gain + F.lane + 64 * j);
      for (int m0 = 4 * gw; m0 < M; m0 += 4 * NGW) {
        f32x4 v[4][4]; float sq[4];
#pragma unroll
        for (int r = 0; r < 4; ++r) { const GAS f32x4* xr = (const GAS f32x4*)(P.x + (size_t)(m0 + r) * DMODEL) + F.lane;
#pragma unroll
            for (int j = 0; j < 4; ++j) v[r][j] = xr[64 * j]; }
#pragma unroll
        for (int r = 0; r < 4; ++r) { float s = 0.f;
#pragma unroll
            for (int j = 0; j < 4; ++j) s += (v[r][j].x * v[r][j].x + v[r][j].y * v[r][j].y) + (v[r][j].z * v[r][j].z + v[r][j].w * v[r][j].w);
            sq[r] = s; }
#pragma unroll
        for (int o = 1; o < 64; o <<= 1) {
#pragma unroll
            for (int r = 0; r < 4; ++r) sq[r] += __shfl_xor(sq[r], o); }
#pragma unroll
        for (int r = 0; r < 4; ++r) { const float rstd = rsqrtf(sq[r] * (1.f / DMODEL) + EPS);
            GAS unsigned long long* o8 = (GAS unsigned long long*)(P.XN + (size_t)(m0 + r) * DMODEL) + F.lane;
#pragma unroll
            for (int j = 0; j < 4; ++j) o8[64 * j] = (unsigned long long)pk2(v[r][j].x * rstd * g[j].x, v[r][j].y * rstd * g[j].y) | ((unsigned long long)pk2(v[r][j].z * rstd * g[j].z, v[r][j].w * rstd * g[j].w) << 32); }
      } }
    { const int gt = F.vcu * (NWAVES * 64) + F.tid, NGT = F.G * NWAVES * 64;
      for (int e = gt; e < M * 16; e += NGT) { const int row = e >> 4, i = e & 15;
          const float ang = (float)P.positions[row] * inv_freq(i);
          const double rev = (double)ang * 0.15915494309189533576888; const double f = rev - rint(rev);
          float s, c; sincos_rev(f, s, c); P.CS[(size_t)row * 32 + i] = c; P.CS[(size_t)row * 32 + 16 + i] = s; }
      for (int e = gt; e < 3 * 8 * 192; e += NGT) { const int p = e / (8 * 192), h = (e / 192) % 8, ix = e % 192; const int delta = ix - 31; const int dil = p == 0 ? 1 : p == 1 ? 4 : 16;
          float v = -INFINITY; if (delta >= 0 && delta <= 128) v = LOG2E * P.rel_bias[t5_bucket(delta * dil) * 8 + h];
          P.BT[e] = v; }
    }
}

typedef pg8::Unit Unit;
__device__ __forceinline__ float dot4(const f32x4 a) { return (a[0] * a[0] + a[1] * a[1]) + (a[2] * a[2] + a[3] * a[3]); }
__device__ __forceinline__ float qsum(float s) { s += __shfl_xor(s, 16); s += __shfl_xor(s, 32); return s; }
__device__ __forceinline__ v4u pack8(const f32x4 a, const f32x4 b) { v4u w; w.x = pk2(a[0], a[1]); w.y = pk2(a[2], a[3]); w.z = pk2(b[0], b[1]); w.w = pk2(b[2], b[3]); return w; }
__device__ __forceinline__ float silu1(float z) { return z * __builtin_amdgcn_rcpf(1.0f + __builtin_amdgcn_exp2f(-z * LOG2E)); }
__device__ __forceinline__ f32x4 silu4(const f32x4 z) { return (f32x4){silu1(z[0]), silu1(z[1]), silu1(z[2]), silu1(z[3])}; }
__device__ __forceinline__ void rope8(f32x4& t0, f32x4& t1, const float* cs, int fq) {
    f32x4 p0, p1;
#pragma unroll
    for (int e = 0; e < 4; ++e) { p0[e] = __shfl_xor(t0[e], 32); p1[e] = __shfl_xor(t1[e], 32); }
    const f32x4 c0 = *(const f32x4*)(cs + 8 * (fq & 1)), c1 = *(const f32x4*)(cs + 8 * (fq & 1) + 4), s0 = *(const f32x4*)(cs + 16 + 8 * (fq & 1)), s1 = *(const f32x4*)(cs + 16 + 8 * (fq & 1) + 4);
    const float sg = fq < 2 ? -1.0f : 1.0f;
    t0 = t0 * c0 + sg * (p0 * s0); t1 = t1 * c1 + sg * (p1 * s1);
}

__device__ __forceinline__ unsigned swap_adj(unsigned v) { return (unsigned)__builtin_amdgcn_update_dpp(0, (int)v, 0xB1, 0xF, 0xF, false); }
__device__ __forceinline__ void store_rows2(bf16* p, int stride, const v4u A, const v4u B, int e) {
    v4u d1, d2;
#pragma unroll
    for (int k = 0; k < 4; ++k) { const unsigned snd = e ? A[k] : B[k], rcv = swap_adj(snd); d1[k] = e ? rcv : A[k]; d2[k] = e ? B[k] : rcv; }
    bf16* p1 = p + (e ? 32 - stride : 0);
    *(v4u*)p1 = d1; *(v4u*)(p1 + stride) = d2;
}
struct EpiP1 {
    static constexpr bool PERM = true, AFTER_DRAIN = false, INIT = false;
    unsigned char* ws;
    __device__ __forceinline__ void operator()(const f32x4 (&acc)[2][2][4][2], const Unit& u, int wr, int wc, int fr_, int fq_) const {
        int fr = fr_, fq = fq_; asm volatile("" : "+v"(fr), "+v"(fq));
        bf16 *QA = (bf16*)(ws + WS_QA), *KA = (bf16*)(ws + WS_KA), *VA = (bf16*)(ws + WS_VA), *SZ = (bf16*)(ws + WS_SZ), *CQ = (bf16*)(ws + WS_CQ), *CKV = (bf16*)(ws + WS_CKV), *KR = (bf16*)(ws + WS_KR);
        float* SSQ = (float*)(ws + WS_SSQ); const float *GN = (const float*)(ws + WS_GN), *aq = GN + GN_AQ, *ak = GN + GN_AK, *krg = GN + GN_KR, *CS = (const float*)(ws + WS_CS);
        const int pn = u.pn; const int row0 = u.pm * 256 + wr * 64 + fr;
        if (pn < 4) {
            const float* g = pn < 2 ? aq : ak; const float sc = pn < 2 ? SCALE_A : 1.0f; bf16* dst = (pn < 2 ? QA : KA) + (4 * (pn & 1) + wc) * 64 + 8 * fq;
            const f32x4 g00 = *(const f32x4*)(g + 8 * fq), g01 = *(const f32x4*)(g + 8 * fq + 4), g10 = *(const f32x4*)(g + 32 + 8 * fq), g11 = *(const f32x4*)(g + 32 + 8 * fq + 4);
#pragma unroll
            for (int ai = 0; ai < 2; ++ai)
#pragma unroll
                for (int m = 0; m < 4; ++m) { const f32x4 a0 = acc[ai][0][m][0], a1 = acc[ai][0][m][1], b0 = acc[ai][1][m][0], b1 = acc[ai][1][m][1];
                    const float ss = qsum((dot4(a0) + dot4(a1)) + (dot4(b0) + dot4(b1))); const float rs = rsqrtf(ss * (1.0f / 64.0f) + EPS) * sc;
                    bf16* p = dst + (size_t)(row0 + ai * 128 + m * 16) * 512;
                    store_rows2(p, 512, pack8(a0 * g00 * rs, a1 * g01 * rs), pack8(b0 * g10 * rs, b1 * g11 * rs), fr & 1); }
        } else if (pn < 6) {
            bf16* dst = VA + (4 * (pn & 1) + wc) * 64 + 8 * fq;
#pragma unroll
            for (int ai = 0; ai < 2; ++ai)
#pragma unroll
                for (int m = 0; m < 4; ++m) { bf16* p = dst + (size_t)(row0 + ai * 128 + m * 16) * 512;
                    store_rows2(p, 512, pack8(acc[ai][0][m][0], acc[ai][0][m][1]), pack8(acc[ai][1][m][0], acc[ai][1][m][1]), fr & 1); }
        } else if (pn < 10) {
            bf16* dst = SZ + (pn - 6) * 256 + wc * 64 + 8 * fq;
#pragma unroll
            for (int ai = 0; ai < 2; ++ai)
#pragma unroll
                for (int m = 0; m < 4; ++m) { bf16* p = dst + (size_t)(row0 + ai * 128 + m * 16) * 1024;
                    store_rows2(p, 1024, pack8(silu4(acc[ai][0][m][0]), silu4(acc[ai][0][m][1])), pack8(silu4(acc[ai][1][m][0]), silu4(acc[ai][1][m][1])), fr & 1); }
        } else if (pn == 10) {
            bf16* dst = CQ + wc * 64 + 8 * fq;
#pragma unroll
            for (int ai = 0; ai < 2; ++ai)
#pragma unroll
                for (int m = 0; m < 4; ++m) { const f32x4 a0 = acc[ai][0][m][0], a1 = acc[ai][0][m][1], b0 = acc[ai][1][m][0], b1 = acc[ai][1][m][1]; const int row = row0 + ai * 128 + m * 16;
                    const float ss = qsum((dot4(a0) + dot4(a1)) + (dot4(b0) + dot4(b1))); if (fq == 0) SSQ[(size_t)row * 8 + wc] = ss;
                    bf16* p = dst + (size_t)row * 256; store_rows2(p, 256, pack8(a0, a1), pack8(b0, b1), fr & 1); }
        } else {
            if (wc < 2) {
                bf16* dst = CKV + wc * 64 + 8 * fq;
#pragma unroll
                for (int ai = 0; ai < 2; ++ai)
#pragma unroll
                    for (int m = 0; m < 4; ++m) { const f32x4 a0 = acc[ai][0][m][0], a1 = acc[ai][0][m][1], b0 = acc[ai][1][m][0], b1 = acc[ai][1][m][1]; const int row = row0 + ai * 128 + m * 16;
                        const float ss = qsum((dot4(a0) + dot4(a1)) + (dot4(b0) + dot4(b1))); if (fq == 0) SSQ[(size_t)row * 8 + 4 + wc] = ss;
                        bf16* p = dst + (size_t)row * 128; store_rows2(p, 128, pack8(a0, a1), pack8(b0, b1), fr & 1); }
            } else if (wc == 2) {
                const f32x4 g0 = *(const f32x4*)(krg + 8 * fq), g1 = *(const f32x4*)(krg + 8 * fq + 4);
#pragma unroll
                for (int ai = 0; ai < 2; ++ai)
#pragma unroll
                    for (int m = 0; m < 4; ++m) { const f32x4 a0 = acc[ai][0][m][0], a1 = acc[ai][0][m][1]; const int row = row0 + ai * 128 + m * 16;
                        const float ss = qsum(dot4(a0) + dot4(a1)); const float rs = rsqrtf(ss * (1.0f / 32.0f) + EPS);
                        f32x4 t0 = a0 * g0 * rs, t1 = a1 * g1 * rs; rope8(t0, t1, CS + (size_t)row * 32, fq);
                        *(v4u*)(KR + (size_t)row * 32 + 8 * fq) = pack8(t0, t1); }
            }
        }
    }
};
struct EpiP2q {
    static constexpr bool PERM = true, AFTER_DRAIN = false, INIT = false;
    unsigned char* ws;
    __device__ __forceinline__ void operator()(const f32x4 (&acc)[2][2][4][2], const Unit& u, int wr, int wc, int fr_, int fq_) const {
        int fr = fr_, fq = fq_; asm volatile("" : "+v"(fr), "+v"(fq));
        bf16* QB = (bf16*)(ws + WS_QB); const float *SSQ = (const float*)(ws + WS_SSQ), *GN = (const float*)(ws + WS_GN), *qn = GN + GN_QN, *qr = GN + GN_QR, *CS = (const float*)(ws + WS_CS);
        const int pn = u.pn; const int row0 = u.pm * 256 + wr * 64 + fr;
        if (pn < 2) {
            bf16* dst = QB + (4 * pn + wc) * 96 + 8 * fq;
            const f32x4 g00 = *(const f32x4*)(qn + 8 * fq), g01 = *(const f32x4*)(qn + 8 * fq + 4), g10 = *(const f32x4*)(qn + 32 + 8 * fq), g11 = *(const f32x4*)(qn + 32 + 8 * fq + 4);
#pragma unroll
            for (int ai = 0; ai < 2; ++ai)
#pragma unroll
                for (int m = 0; m < 4; ++m) { const int row = row0 + ai * 128 + m * 16; const f32x4 sq = *(const f32x4*)(SSQ + (size_t)row * 8);
                    const float rc = rsqrtf(((sq[0] + sq[1]) + (sq[2] + sq[3])) * (1.0f / 256.0f) + EPS);
                    const f32x4 a0 = acc[ai][0][m][0] * rc, a1 = acc[ai][0][m][1] * rc, b0 = acc[ai][1][m][0] * rc, b1 = acc[ai][1][m][1] * rc;
                    const float ss = qsum((dot4(a0) + dot4(a1)) + (dot4(b0) + dot4(b1))); const float rs = rsqrtf(ss * (1.0f / 64.0f) + EPS) * SCALE_B;
                    bf16* p = dst + (size_t)row * 768; *(v4u*)p = pack8(a0 * g00 * rs, a1 * g01 * rs); *(v4u*)(p + 32) = pack8(b0 * g10 * rs, b1 * g11 * rs); asm volatile("" ::: "memory"); }
        } else {
            const f32x4 g0 = *(const f32x4*)(qr + 8 * fq), g1 = *(const f32x4*)(qr + 8 * fq + 4);
#pragma unroll
            for (int ai = 0; ai < 2; ++ai)
#pragma unroll
                for (int m = 0; m < 4; ++m) { const int row = row0 + ai * 128 + m * 16; const f32x4 sq = *(const f32x4*)(SSQ + (size_t)row * 8);
                    const float rc = rsqrtf(((sq[0] + sq[1]) + (sq[2] + sq[3])) * (1.0f / 256.0f) + EPS);
#pragma unroll
                    for (int bj = 0; bj < 2; ++bj) { const f32x4 a0 = acc[ai][bj][m][0] * rc, a1 = acc[ai][bj][m][1] * rc;
                        const float ss = qsum(dot4(a0) + dot4(a1)); const float rs = rsqrtf(ss * (1.0f / 32.0f) + EPS);
                        f32x4 t0 = a0 * g0 * rs, t1 = a1 * g1 * rs; rope8(t0, t1, CS + (size_t)row * 32, fq);
                        *(v4u*)(QB + (size_t)row * 768 + (2 * wc + bj) * 96 + 64 + 8 * fq) = pack8(t0 * SCALE_B, t1 * SCALE_B); asm volatile("" ::: "memory"); } }
        }
    }
};
struct EpiP2kv {
    static constexpr bool PERM = true, AFTER_DRAIN = false, INIT = false;
    unsigned char* ws;
    __device__ __forceinline__ void operator()(const f32x4 (&acc)[2][2][4][2], const Unit& u, int wr, int wc, int fr_, int fq_) const {
        int fr = fr_, fq = fq_; asm volatile("" : "+v"(fr), "+v"(fq));
        bf16 *KN = (bf16*)(ws + WS_KN), *VB = (bf16*)(ws + WS_VB); const float *SSQ = (const float*)(ws + WS_SSQ), *kn = (const float*)(ws + WS_GN) + GN_KN;
        const int pn = u.pn; const int row0 = u.pm * 256 + wr * 64 + fr;
        bf16* dst = (pn < 2 ? KN : VB) + (4 * (pn & 1) + wc) * 64 + 8 * fq;
        f32x4 g00 = (f32x4){1.f, 1.f, 1.f, 1.f}, g01 = g00, g10 = g00, g11 = g00;
        if (pn < 2) { g00 = *(const f32x4*)(kn + 8 * fq); g01 = *(const f32x4*)(kn + 8 * fq + 4); g10 = *(const f32x4*)(kn + 32 + 8 * fq); g11 = *(const f32x4*)(kn + 32 + 8 * fq + 4); }
#pragma unroll
        for (int ai = 0; ai < 2; ++ai)
#pragma unroll
            for (int m = 0; m < 4; ++m) { const int row = row0 + ai * 128 + m * 16;
                const float rc = rsqrtf((SSQ[(size_t)row * 8 + 4] + SSQ[(size_t)row * 8 + 5]) * (1.0f / 128.0f) + EPS);
                const f32x4 a0 = acc[ai][0][m][0] * rc, a1 = acc[ai][0][m][1] * rc, b0 = acc[ai][1][m][0] * rc, b1 = acc[ai][1][m][1] * rc;
                float rs = 1.0f;
                if (pn < 2) { const float ss = qsum((dot4(a0) + dot4(a1)) + (dot4(b0) + dot4(b1))); rs = rsqrtf(ss * (1.0f / 64.0f) + EPS); }
                bf16* p = dst + (size_t)row * 512; *(v4u*)p = pack8(a0 * g00 * rs, a1 * g01 * rs); *(v4u*)(p + 32) = pack8(b0 * g10 * rs, b1 * g11 * rs); asm volatile("" ::: "memory"); }
    }
};
__device__ __forceinline__ void store_rows2f(float* p, const f32x4 A, const f32x4 B, int e) {
    f32x4 d1, d2;
#pragma unroll
    for (int k = 0; k < 4; ++k) { const float snd = e ? A[k] : B[k], rcv = __uint_as_float(swap_adj(__float_as_uint(snd))); d1[k] = e ? rcv : A[k]; d2[k] = e ? B[k] : rcv; }
    float* p1 = p + (e ? 16 - 1024 : 0);
    __builtin_nontemporal_store(d1, (f32x4*)p1); __builtin_nontemporal_store(d2, (f32x4*)(p1 + 1024));
}
__device__ __forceinline__ void load_rows2f(const float* p, f32x4& A, f32x4& B, int e) {
    const float* p1 = p + (e ? 16 - 1024 : 0);
    const f32x4 d1 = __builtin_nontemporal_load((const f32x4*)p1), d2 = __builtin_nontemporal_load((const f32x4*)(p1 + 1024));
#pragma unroll
    for (int k = 0; k < 4; ++k) { const float snd = e ? d1[k] : d2[k], rcv = __uint_as_float(swap_adj(__float_as_uint(snd))); A[k] = e ? rcv : d1[k]; B[k] = e ? d2[k] : rcv; }
}
struct EpiOut {
    static constexpr bool PERM = false, AFTER_DRAIN = false, INIT = true;
    const float* x; float* out;
    __device__ __forceinline__ void init(f32x4 (&acc)[2][2][4][2], const Unit& u, int wr, int wc, int fr_, int fq_) const {
        int fr = fr_, fq = fq_; asm volatile("" : "+v"(fr), "+v"(fq));
        const int row0 = u.pm * 256 + wr * 64 + fr, col0 = u.pn * 256 + wc * 32 + 4 * fq;
#pragma unroll
        for (int ai = 0; ai < 2; ++ai)
#pragma unroll
            for (int m = 0; m < 4; ++m) { const size_t off = (size_t)(row0 + ai * 128 + m * 16) * 1024 + col0;
#pragma unroll
                for (int bj = 0; bj < 2; ++bj) load_rows2f(x + off + bj * 128, acc[ai][bj][m][0], acc[ai][bj][m][1], fr & 1); }
    }
    __device__ __forceinline__ void operator()(const f32x4 (&acc)[2][2][4][2], const Unit& u, int wr, int wc, int fr_, int fq_) const {
        int fr = fr_, fq = fq_; asm volatile("" : "+v"(fr), "+v"(fq));
        const int row0 = u.pm * 256 + wr * 64 + fr, col0 = u.pn * 256 + wc * 32 + 4 * fq;
#pragma unroll
        for (int ai = 0; ai < 2; ++ai)
#pragma unroll
            for (int m = 0; m < 4; ++m) { const size_t off = (size_t)(row0 + ai * 128 + m * 16) * 1024 + col0;
#pragma unroll
                for (int bj = 0; bj < 2; ++bj) store_rows2f(out + off + bj * 128, acc[ai][bj][m][0], acc[ai][bj][m][1], fr & 1); }
    }
};

typedef LAS const char* lds_cptr;
typedef short v4i16_t __attribute__((ext_vector_type(4)));
__device__ __forceinline__ s16x4 vtr(lds_cptr p) { return __builtin_bit_cast(s16x4, __builtin_amdgcn_ds_read_tr16_b64_v4i16((LAS v4i16_t*)p)); }
#define MFMA32(a, b, c) __builtin_amdgcn_mfma_f32_32x32x16_bf16(a, b, c, 0, 0, 0)
__device__ __forceinline__ float half_swap_add(float v) { auto rr = __builtin_amdgcn_permlane32_swap(__float_as_uint(v), __float_as_uint(v), false, false); return __uint_as_float(rr[0]) + __uint_as_float(rr[1]); }

namespace mla2 {
constexpr int KSLOT = 12288, VSLOT = 8192, NSLOT = 3;
constexpr int LDS_K = 0, LDS_V = NSLOT * KSLOT, LDS_WS = LDS_V + NSLOT * VSLOT, LDS_OST = LDS_WS + NWAVES * 256, LDS_SZ = LDS_OST + NWAVES * 4096, LDS_TOTAL = LDS_SZ + NWAVES * 4096;
#define SBAR() __builtin_amdgcn_sched_barrier(0)
#define PIN(x) asm volatile("" : "+v"(x))
#define WAIT_BAR(N) asm volatile("s_waitcnt vmcnt(" #N ") lgkmcnt(0)\n\ts_barrier" ::: "memory")
__device__ __forceinline__ void glds16s(const void* sbase, unsigned voff, unsigned lds_base) {
    unsigned sv; asm volatile("s_mov_b32 %0, m0\n\ts_mov_b32 m0, %3\n\ts_nop 0\n\tglobal_load_lds_dwordx4 %1, %2\n\ts_mov_b32 m0, %0" : "=&s"(sv) : "v"(voff), "s"(sbase), "s"(lds_base) : "memory"); }
__device__ __forceinline__ void kload2(bf16x8* kf, lds_cptr kp, int d0) { kf[2 * d0] = *(const LAS bf16x8*)(kp + d0 * 2048); kf[2 * d0 + 1] = *(const LAS bf16x8*)(kp + d0 * 2048 + 512); }
__device__ __forceinline__ void cmask(f32x16& p0, f32x16& p1, int jb, int qrel, int hi) {
    const int kb = 64 * jb + 4 * hi;
#pragma unroll
    for (int r = 0; r < 16; ++r) { const int kv = kb + (r & 3) + 8 * (r >> 2); if (kv > qrel) p0[r] = -INFINITY; if (kv + 32 > qrel) p1[r] = -INFINITY; } }

__device__ __forceinline__ void unit(int b, int h, int qb, const MlaT T, char* lds) {
    const int tid = threadIdx.x, lane = tid & 63, r32 = lane & 31, hi = lane >> 5; const int wid = __builtin_amdgcn_readfirstlane(tid >> 6);
    const long rowbase = (long)b * SEQ; const int q0 = qb * 256, NT = (q0 + 256) / 64;
    const bf16* Qw = T.QB + (rowbase + q0 + wid * 32) * 768 + h * 96;
    const unsigned lds0 = (unsigned)(uintptr_t)lds;
    const bf16* const kbn = T.KN + rowbase * 512 + h * 64; const bf16* const kbr = T.KR + rowbase * 32; const bf16* const vbs = T.VB + rowbase * 512 + h * 64;
    const unsigned kon = (unsigned)lane * 1024u + (unsigned)wid * 16u, kor = (unsigned)lane * 64u + (unsigned)(wid & 3) * 16u;
    const unsigned vof = (unsigned)(16 * (wid & 3) + (lane >> 2)) * 1024u + (unsigned)(wid >> 2) * 64u + (unsigned)(lane & 3) * 16u;
    const unsigned kdn = lds0 + LDS_K + wid * 1024, kdr = lds0 + LDS_K + (8 + (wid & 3)) * 1024, vdst = lds0 + LDS_V + wid * 1024;
#define DMA_K(t, slot) do { glds16s(kbn + (long)(t) * 64 * 512, kon, (unsigned)__builtin_amdgcn_readfirstlane(kdn + (slot))); glds16s(kbr + (long)(t) * 64 * 32, kor, (unsigned)__builtin_amdgcn_readfirstlane(kdr + (slot))); } while (0)
#define DMA_V(t, slot) glds16s(vbs + (long)(t) * 64 * 512, vof, (unsigned)__builtin_amdgcn_readfirstlane(vdst + (slot)))
    const lds_cptr vp0 = (lds_cptr)lds + LDS_V + ((lane >> 4) & 1) * 32 + (lane & 3) * 8 + (4 * hi + ((lane & 15) >> 2)) * 64;
    const lds_cptr kp0 = (lds_cptr)lds + LDS_K + hi * 1024 + r32 * 16;
    DMA_K(0, 0); DMA_V(0, 0); DMA_K(1, KSLOT);
    bf16x8 qr[6];
#pragma unroll
    for (int d0 = 0; d0 < 6; ++d0) qr[d0] = *reinterpret_cast<const bf16x8*>(&Qw[(long)r32 * 768 + d0 * 16 + hi * 8]);
    float l_reg = 0.f; f32x16 o[2]; o[0] = f32x16{}; o[1] = f32x16{};
    const f32x16 zero16 = f32x16{};
    const int qrel = wid * 32 + r32;
    f32x16 pA0, pA1, pB0, pB1; bf16x8 kf[12]; s16x4 vlo[8], vhi[8]; v4u pw0, pw1, pw2, pw3;
    int ks_cur = 0, ks_next = KSLOT, vs_prev = 0, vs_cur = 0, vs_next = VSLOT;
#define ROT() do { ks_cur = ks_next; ks_next = (ks_next == 2 * KSLOT) ? 0 : ks_next + KSLOT; vs_prev = vs_cur; vs_cur = vs_next; vs_next = (vs_next == 2 * VSLOT) ? 0 : vs_next + VSLOT; } while (0)
#define EX(v) __builtin_amdgcn_exp2f(v)
    DMA_K(2, 2 * KSLOT);
    WAIT_BAR(5);
#pragma unroll
    for (int d0 = 0; d0 < 6; ++d0) kload2(kf, kp0, d0);
    pA0 = MFMA32(kf[0], qr[0], zero16); pA1 = MFMA32(kf[1], qr[0], zero16);
#pragma unroll
    for (int d0 = 1; d0 < 6; ++d0) { pA0 = MFMA32(kf[2 * d0], qr[d0], pA0); pA1 = MFMA32(kf[2 * d0 + 1], qr[d0], pA1); }
    if (NT == 4) cmask(pA0, pA1, 0, qrel, hi);
#pragma unroll
    for (int r = 0; r < 16; ++r) { pA0[r] = EX(pA0[r]); pA1[r] = EX(pA1[r]); }
    WAIT_BAR(0);
    DMA_K(3, 0); DMA_V(1, VSLOT); ROT();
#pragma unroll
    for (int d0 = 0; d0 < 6; ++d0) kload2(kf, kp0 + ks_cur, d0);
    WAIT_BAR(3);
    { const bf16* zb = T.SZ + (rowbase + q0 + wid * 32) * 1024 + 512 + h * 64; const unsigned zo = (unsigned)(lane >> 3) * 2048u + (unsigned)(lane & 7) * 16u;
#pragma unroll
      for (int i = 0; i < 4; ++i) glds16s(zb + (long)(8 * i) * 1024, zo, (unsigned)__builtin_amdgcn_readfirstlane(lds0 + LDS_SZ + wid * 4096 + i * 1024)); }
#define PKW(P, i) pk2(P[i], P[i + 1])
#define PAF(k) __builtin_bit_cast(bf16x8, pw##k)
#define VFR(i) (bf16x8){vlo[i][0], vlo[i][1], vlo[i][2], vlo[i][3], vhi[i][0], vhi[i][1], vhi[i][2], vhi[i][3]}
#define VRD(i) do { vlo[i] = vtr(vp_ + (((i) >> 2) * 4096 + ((i) & 3) * 1024)); vhi[i] = vtr(vp_ + (((i) >> 2) * 4096 + ((i) & 3) * 1024 + 512)); } while (0)
#define KRD(G, d0) do { if (G) { kload2(kf, kp0 + ks_next, d0); SBAR(); } } while (0)
#define GA3(MF, a0, a1, a2, WW, PW) do { MF; sacc += a0; sacc += a1; sacc += a2; WW; PIN(PW); PIN(sacc); SBAR(); } while (0)
#define GAPB(MF, X, i) do { MF; X[i] = EX(X[i]); X[i + 1] = EX(X[i + 1]); X[i + 2] = EX(X[i + 2]); X[i + 3] = EX(X[i + 3]); PIN(X); SBAR(); } while (0)
#define STEP(C0, C1, P0, P1, t, MASK, GK, GV, GL) do { SBAR(); \
    const lds_cptr vp_ = vp0 + vs_prev; \
    VRD(0); SBAR(); float sacc = P0[0] + P0[1]; \
                    GA3(C0 = MFMA32(kf[0], qr[0], zero16), P0[2], P0[3], P0[4],   pw0[0] = PKW(P0, 0); pw0[1] = PKW(P0, 2),   pw0); \
    VRD(4); SBAR(); GA3(C1 = MFMA32(kf[1], qr[0], zero16), P0[5], P0[6], P0[7],   pw0[2] = PKW(P0, 4); pw0[3] = PKW(P0, 6),   pw0); \
    VRD(1); SBAR(); GA3(C0 = MFMA32(kf[2], qr[1], C0),     P0[8], P0[9], P0[10],  pw1[0] = PKW(P0, 8); pw1[1] = PKW(P0, 10),  pw1); \
    VRD(5); SBAR(); GA3(C1 = MFMA32(kf[3], qr[1], C1),     P0[11], P0[12], P0[13], pw1[2] = PKW(P0, 12); pw1[3] = PKW(P0, 14), pw1); \
    VRD(2); SBAR(); GA3(C0 = MFMA32(kf[4], qr[2], C0),     P0[14], P0[15], P1[0], pw2[0] = PKW(P1, 0),  pw2); \
    VRD(6); SBAR(); GA3(C1 = MFMA32(kf[5], qr[2], C1),     P1[1], P1[2], P1[3],   pw2[1] = PKW(P1, 2),  pw2); \
    VRD(3); SBAR(); GA3(C0 = MFMA32(kf[6], qr[3], C0),     P1[4], P1[5], P1[6],   pw2[2] = PKW(P1, 4),  pw2); \
    VRD(7); SBAR(); GA3(C1 = MFMA32(kf[7], qr[3], C1),     P1[7], P1[8], P1[9],   pw2[3] = PKW(P1, 6),  pw2); \
                    GA3(C0 = MFMA32(kf[8], qr[4], C0),     P1[10], P1[11], P1[12], pw3[0] = PKW(P1, 8),  pw3); \
                    GA3(C1 = MFMA32(kf[9], qr[4], C1),     P1[13], P1[14], P1[15], pw3[1] = PKW(P1, 10), pw3); \
                    GA3(C0 = MFMA32(kf[10], qr[5], C0),    0.f, 0.f, 0.f,          pw3[2] = PKW(P1, 12), pw3); \
                    GA3(C1 = MFMA32(kf[11], qr[5], C1),    0.f, 0.f, 0.f,          pw3[3] = PKW(P1, 14), pw3); \
    l_reg += sacc; \
    if (GK) DMA_K((t) + 3, ks_cur); if (GV) DMA_V((t) + 1, vs_next); \
    if (MASK) cmask(C0, C1, (t) - (NT - 4), qrel, hi); \
    SBAR(); \
    GAPB(o[0] = MFMA32(PAF(0), VFR(0), o[0]), C0, 0);              KRD(GL, 0); GAPB(o[1] = MFMA32(PAF(0), VFR(4), o[1]), C0, 4); \
    KRD(GL, 1); GAPB(o[0] = MFMA32(PAF(1), VFR(1), o[0]), C0, 8);  KRD(GL, 2); GAPB(o[1] = MFMA32(PAF(1), VFR(5), o[1]), C0, 12); \
    KRD(GL, 3); GAPB(o[0] = MFMA32(PAF(2), VFR(2), o[0]), C1, 0);  KRD(GL, 4); GAPB(o[1] = MFMA32(PAF(2), VFR(6), o[1]), C1, 4); \
    KRD(GL, 5); GAPB(o[0] = MFMA32(PAF(3), VFR(3), o[0]), C1, 8);              GAPB(o[1] = MFMA32(PAF(3), VFR(7), o[1]), C1, 12); \
    } while (0)
    int t = 1;
    for (; t + 5 < NT; t += 2) {
        STEP(pB0, pB1, pA0, pA1, t, false, true, true, true);     WAIT_BAR(3); ROT();
        STEP(pA0, pA1, pB0, pB1, t + 1, false, true, true, true); WAIT_BAR(3); ROT();
    }
#define ENDW(tt) do { if ((tt) + 3 < NT) { WAIT_BAR(3); } else if ((tt) + 2 < NT) { WAIT_BAR(1); } else { WAIT_BAR(0); } } while (0)
    for (; t + 1 < NT; t += 2) {
        STEP(pB0, pB1, pA0, pA1, t, (t >= NT - 4), (t + 3 < NT), (t + 1 < NT), (t + 1 < NT));         ENDW(t);     ROT();
        STEP(pA0, pA1, pB0, pB1, t + 1, (t + 1 >= NT - 4), (t + 4 < NT), (t + 2 < NT), (t + 2 < NT)); ENDW(t + 1); ROT();
    }
    STEP(pB0, pB1, pA0, pA1, NT - 1, true, false, false, false);
    { float sacc = pB0[0] + pB0[1];
#pragma unroll
      for (int r = 2; r < 16; ++r) sacc += pB0[r];
#pragma unroll
      for (int r = 0; r < 16; ++r) sacc += pB1[r];
      l_reg += sacc;
      pw0 = (v4u){PKW(pB0, 0), PKW(pB0, 2), PKW(pB0, 4), PKW(pB0, 6)}; pw1 = (v4u){PKW(pB0, 8), PKW(pB0, 10), PKW(pB0, 12), PKW(pB0, 14)};
      pw2 = (v4u){PKW(pB1, 0), PKW(pB1, 2), PKW(pB1, 4), PKW(pB1, 6)}; pw3 = (v4u){PKW(pB1, 8), PKW(pB1, 10), PKW(pB1, 12), PKW(pB1, 14)};
      SBAR();
      const lds_cptr vp_ = vp0 + vs_cur;
#pragma unroll
      for (int i = 0; i < 8; ++i) VRD(i);
      o[0] = MFMA32(PAF(0), VFR(0), o[0]); o[1] = MFMA32(PAF(0), VFR(4), o[1]); o[0] = MFMA32(PAF(1), VFR(1), o[0]); o[1] = MFMA32(PAF(1), VFR(5), o[1]);
      o[0] = MFMA32(PAF(2), VFR(2), o[0]); o[1] = MFMA32(PAF(2), VFR(6), o[1]); o[0] = MFMA32(PAF(3), VFR(3), o[0]); o[1] = MFMA32(PAF(3), VFR(7), o[1]); }
    l_reg = half_swap_add(l_reg);
    int ln = lane; asm volatile("" : "+v"(ln));
    const int r32e = ln & 31, hie = ln >> 5;
    LAS float* wsf = (LAS float*)((LAS unsigned char*)lds + LDS_WS) + wid * 64;
    if (hie == 0) wsf[r32e] = l_reg;
    asm volatile("s_waitcnt lgkmcnt(0)" ::: "memory");
    float rli[16];
#pragma unroll
    for (int r = 0; r < 16; ++r) rli[r] = __builtin_amdgcn_rcpf(wsf[crow(r, hie)]);
    { LAS float* stg = (LAS float*)((LAS unsigned char*)lds + LDS_OST) + wid * 1024;
      const size_t obase = (size_t)(rowbase + q0 + wid * 32) * 1024 + 512 + h * 64;
#pragma unroll
      for (int d0 = 0; d0 < 2; ++d0) {
#pragma unroll
          for (int r = 0; r < 16; ++r) stg[crow(r, hie) * 32 + r32e] = o[d0][r] * rli[r];
          asm volatile("s_waitcnt lgkmcnt(0)" ::: "memory");
#pragma unroll
          for (int i = 0; i < 4; ++i) { const int row = i * 8 + (ln >> 3), ch = ln & 7; const f32x4 v = *(const LAS f32x4*)(stg + row * 32 + ch * 4);
              const size_t off = obase + (size_t)row * 1024 + d0 * 32 + ch * 4;
              const unsigned long long z = *(const LAS unsigned long long*)((LAS unsigned char*)lds + LDS_SZ + wid * 4096 + row * 128 + (d0 * 32 + ch * 4) * 2); const unsigned zl = (unsigned)z, zh = (unsigned)(z >> 32);
              const unsigned long long w = (unsigned long long)pk2(v[0] * bflo(zl), v[1] * bfhi(zl)) | ((unsigned long long)pk2(v[2] * bflo(zh), v[3] * bfhi(zh)) << 32);
              *(unsigned long long*)(T.MIX + off) = w; }
          asm volatile("s_waitcnt lgkmcnt(0)" ::: "memory");
      } }
    asm volatile("s_waitcnt lgkmcnt(0)\n\ts_barrier" ::: "memory");
#undef DMA_K
#undef DMA_V
#undef ROT
#undef EX
#undef PKW
#undef PAF
#undef VFR
#undef VRD
#undef KRD
#undef GA3
#undef GAPB
#undef STEP
#undef ENDW
}
#undef SBAR
#undef PIN
#undef WAIT_BAR
}

namespace dil4 {
constexpr int SLOT = 8192, WAVE_LDS = 2 * SLOT;
constexpr int TBC = 208;
constexpr int TB_OFF = 132096, WSF_OFF = TB_OFF + 3 * 4 * TBC * 4;
__device__ __forceinline__ void glds16s(const void* sbase, unsigned voff, unsigned lds_base) {
    unsigned sv; asm volatile("s_mov_b32 %0, m0\n\ts_mov_b32 m0, %3\n\ts_nop 0\n\tglobal_load_lds_dwordx4 %1, %2\n\ts_mov_b32 m0, %0" : "=&s"(sv) : "v"(voff), "s"(sbase), "s"(lds_base) : "memory"); }
struct T4 { const bf16 *QA, *KA, *VA; bf16 *OP0, *OP1, *OP2; float* LP; const float* BT; };
__device__ __forceinline__ void build_tables(const float* BT, int h, LAS unsigned char* lds) {
    LAS float* tb = (LAS float*)(lds + TB_OFF);
    for (int e = threadIdx.x; e < 3 * 4 * 192; e += NWAVES * 64) { const int p = e / 768, c = (e / 192) & 3, i = e % 192, ix = 190 - i - c; tb[(p * 4 + c) * TBC + i] = ix >= 0 ? BT[p * (8 * 192) + h * 192 + ix] : -INFINITY; }
}

template <int DIL>
__device__ __forceinline__ void run_task2(int s, int a0, long rowbase, int h, const T4& T, LAS unsigned char* wl, unsigned wl0, const LAS float* tbl, f32x16 (&oA)[2], f32x16 (&oB)[2], float& lA, float& lB, int lane) {
    const int r32 = lane & 31, hi = lane >> 5;
    const bf16* const kb = T.KA + rowbase * 512 + h * 64; const bf16* const vb = T.VA + rowbase * 512 + h * 64;
    unsigned kof[4], vof[4];
#pragma unroll
    for (int i = 0; i < 4; ++i) { const int row = 8 * i + (lane >> 3), ch = (lane & 7) ^ ((row >> 1) & 7); kof[i] = (unsigned)(row * DIL) * 1024u + (unsigned)ch * 16u;
        const int pc = (lane & 7) ^ (((row >> 1) & 1) << 2); vof[i] = (unsigned)(row * DIL) * 1024u + (unsigned)pc * 16u; }
    const int k0 = a0 >= 128 ? 0 : (128 - a0) >> 5;
#define DMA_SUB(k) do { const long tok = (long)(a0 - 128 + 32 * (k)) * DIL + s; const bf16* kbj = kb + tok * 512; const bf16* vbj = vb + tok * 512; const unsigned dst = wl0 + ((k) & 1) * SLOT; \
        _Pragma("unroll") for (int i = 0; i < 4; ++i) glds16s(kbj, kof[i], (unsigned)__builtin_amdgcn_readfirstlane(dst + i * 1024)); \
        _Pragma("unroll") for (int i = 0; i < 4; ++i) glds16s(vbj, vof[i], (unsigned)__builtin_amdgcn_readfirstlane(dst + 4096 + i * 1024)); } while (0)
    { const bf16* qbs = T.QA + (rowbase + (long)a0 * DIL + s) * 512 + h * 64;
#pragma unroll
      for (int i = 0; i < 8; ++i) glds16s(qbs + (long)(8 * (i & ~1)) * DIL * 512, kof[i & 1], (unsigned)__builtin_amdgcn_readfirstlane(wl0 + SLOT + i * 1024)); }
    DMA_SUB(k0);
    asm volatile("s_waitcnt vmcnt(8)" ::: "memory");
    bf16x8 qa[4], qb[4];
    { const LAS unsigned char* qs = wl + SLOT + r32 * 128;
#pragma unroll
      for (int d0 = 0; d0 < 4; ++d0) { qa[d0] = *(const LAS bf16x8*)(qs + (((2 * d0 + hi) ^ ((r32 >> 1) & 7)) * 16)); qb[d0] = *(const LAS bf16x8*)(qs + 4096 + (((2 * d0 + hi) ^ ((r32 >> 1) & 7)) * 16)); } }
    asm volatile("s_waitcnt lgkmcnt(0)" ::: "memory");
    DMA_SUB(k0 + 1);
    oA[0] = f32x16{}; oA[1] = f32x16{}; oB[0] = f32x16{}; oB[1] = f32x16{}; lA = 0.f; lB = 0.f;
    const int kro = r32 * 128, ksw = (r32 >> 1) & 7;
    const int vq = (lane & 15) >> 2, vsw = (vq >> 1) & 1;
    const lds_cptr vp0 = (lds_cptr)wl + 4096 + (4 * hi + vq) * 128 + ((lane >> 4) & 1) * 32 + (lane & 3) * 8;
#define GRP(O, L, Q, j) do { \
        f32x16 pj; { const LAS f32x4* bp = (const LAS f32x4*)(tbl + 32 * (j)); const f32x4 b0 = bp[0], b1 = bp[2], b2 = bp[4], b3 = bp[6]; \
          pj = (f32x16){b0[0], b0[1], b0[2], b0[3], b1[0], b1[1], b1[2], b1[3], b2[0], b2[1], b2[2], b2[3], b3[0], b3[1], b3[2], b3[3]}; } \
        _Pragma("unroll") for (int d0 = 0; d0 < 4; ++d0) pj = MFMA32(kf[d0], Q[d0], pj); \
        float sm = 0.f; \
        _Pragma("unroll") for (int r = 0; r < 16; ++r) { pj[r] = __builtin_amdgcn_exp2f(pj[r]); sm += pj[r]; } \
        L += sm; \
        v4u pw0, pw1; \
        _Pragma("unroll") for (int jj = 0; jj < 4; ++jj) { pw0[jj] = pk2(pj[2 * jj], pj[2 * jj + 1]); pw1[jj] = pk2(pj[8 + 2 * jj], pj[8 + 2 * jj + 1]); } \
        _Pragma("unroll") for (int dh = 0; dh < 2; ++dh) { O[dh] = MFMA32(__builtin_bit_cast(bf16x8, pw0), vf[dh][0], O[dh]); O[dh] = MFMA32(__builtin_bit_cast(bf16x8, pw1), vf[dh][1], O[dh]); } } while (0)
#define COMPUTE2(k) do { if ((k) >= k0) { \
        if ((k) < 5) asm volatile("s_waitcnt vmcnt(8)" ::: "memory"); else asm volatile("s_waitcnt vmcnt(0)" ::: "memory"); \
        const LAS unsigned char* ks = wl + ((k) & 1) * SLOT; \
        bf16x8 kf[4], vf[2][2]; \
        _Pragma("unroll") for (int d0 = 0; d0 < 4; ++d0) kf[d0] = *(const LAS bf16x8*)(ks + kro + (((2 * d0 + hi) ^ ksw) * 16)); \
        { const lds_cptr vp = vp0 + ((k) & 1) * SLOT; \
          _Pragma("unroll") for (int dh = 0; dh < 2; ++dh) { const lds_cptr vd = vp + ((dh ^ vsw) * 64); const s16x4 l0 = vtr(vd), h0 = vtr(vd + 1024), l1 = vtr(vd + 2048), h1 = vtr(vd + 3072); \
              vf[dh][0] = (bf16x8){l0[0], l0[1], l0[2], l0[3], h0[0], h0[1], h0[2], h0[3]}; vf[dh][1] = (bf16x8){l1[0], l1[1], l1[2], l1[3], h1[0], h1[1], h1[2], h1[3]}; } } \
        if ((k) <= 4) GRP(oA, lA, qa, (k)); \
        if ((k) >= 1) GRP(oB, lB, qb, (k) - 1); \
        asm volatile("s_waitcnt lgkmcnt(0)" ::: "memory"); \
        if ((k) + 2 <= 5) DMA_SUB((k) + 2); } } while (0)
    COMPUTE2(0); COMPUTE2(1); COMPUTE2(2); COMPUTE2(3); COMPUTE2(4); COMPUTE2(5);
#undef COMPUTE2
#undef GRP
#undef DMA_SUB
    lA = half_swap_add(lA); lB = half_swap_add(lB);
}
template <int DIL, int P>
__device__ __forceinline__ void store_group(const f32x16 (&o)[2], float l, int s, int a0, long rowbase, int h, const T4& T, LAS float* stg, LAS float* wsf, int lane) {
    const int r32 = lane & 31, hi = lane >> 5;
    if (hi == 0) wsf[r32] = l;
    asm volatile("s_waitcnt lgkmcnt(0)" ::: "memory");
#pragma unroll
    for (int dh = 0; dh < 2; ++dh) {
#pragma unroll
        for (int r = 0; r < 16; ++r) stg[crow(r, hi) * 32 + r32] = o[dh][r];
        asm volatile("s_waitcnt lgkmcnt(0)" ::: "memory");
#pragma unroll
        for (int i = 0; i < 4; ++i) { const int row = i * 8 + (lane >> 3), ch = lane & 7; const f32x4 v = *(const LAS f32x4*)(stg + row * 32 + ch * 4);
            const size_t tok = (size_t)(rowbase + (long)(a0 + row) * DIL + s); const size_t off = tok * 512 + h * 64 + dh * 32 + ch * 4;
            bf16* OP = P == 0 ? T.OP0 : P == 1 ? T.OP1 : T.OP2;
            *(unsigned long long*)(OP + off) = (unsigned long long)pk2(v[0], v[1]) | ((unsigned long long)pk2(v[2], v[3]) << 32);
            if (dh == 0 && ch == 0) T.LP[((size_t)P * M + tok) * 8 + h] = wsf[row]; }
        asm volatile("s_waitcnt lgkmcnt(0)" ::: "memory");
    }
}
template <int DIL, int P>
__device__ __forceinline__ void task2(int bh, int s, int a0, const T4 T, LAS unsigned char* lds) {
    const int tid = threadIdx.x; int lane = tid & 63; asm volatile("" : "+v"(lane)); const int wid = __builtin_amdgcn_readfirstlane(tid >> 6);
    const int r32 = lane & 31, hi = lane >> 5;
    const int b = bh >> 3, h = bh & 7; const long rowbase = (long)b * SEQ;
    LAS unsigned char* wl = lds + wid * WAVE_LDS; const unsigned wl0 = (unsigned)(uintptr_t)(lds) + wid * WAVE_LDS;
    const int ub = r32 - 4 * hi, cpy = (31 - ub) & 3; const LAS float* tlane = (const LAS float*)(lds + TB_OFF) + (P * 4 + cpy) * TBC + (31 - ub - cpy);
    f32x16 oA[2], oB[2]; float lA, lB;
    run_task2<DIL>(s, a0, rowbase, h, T, wl, wl0, tlane, oA, oB, lA, lB, lane);
    LAS float* wsf = (LAS float*)(lds + WSF_OFF) + wid * 32;
    LAS float* stg = (LAS float*)wl;
    store_group<DIL, P>(oA, lA, s, a0, rowbase, h, T, stg, wsf, lane);
    store_group<DIL, P>(oB, lB, s, a0 + 32, rowbase, h, T, stg, wsf, lane);
}
}

namespace dil5 {
using dil4::TBC; using dil4::TB_OFF; using dil4::WSF_OFF; using dil4::glds16s; using dil4::T4;
constexpr int LK = 0, LV = 49152, LST = 98304, CNT_OFF = LDSCTL_OFF + 768;
__device__ __forceinline__ bool chunk_ready(const volatile LAS unsigned* cnt, int ck, unsigned target) { const unsigned v = (unsigned)__builtin_amdgcn_readfirstlane((int)cnt[ck]); return (int)(v - target) >= 0; }

template <int DIL, int P>
__device__ __forceinline__ void segment(int bh, int s, int a0, unsigned target, const T4 T, LAS unsigned char* lds) {
    const int tid = threadIdx.x; int lane = tid & 63; asm volatile("" : "+v"(lane)); const int wid = __builtin_amdgcn_readfirstlane(tid >> 6);
    const int r32 = lane & 31, hi = lane >> 5;
    const int b = bh >> 3, h = bh & 7; const long rowbase = (long)b * SEQ;
    const unsigned lds0 = (unsigned)(uintptr_t)lds;
    asm volatile("s_waitcnt lgkmcnt(0)\n\ts_barrier" ::: "memory");
    const int cmin = a0 == 0 ? 2 : 0;
    { const int lr = lane >> 3;
      const bf16* qb = T.QA + (rowbase + (long)(a0 + 32 * wid) * DIL + s) * 512 + h * 64;
      const unsigned q0 = (unsigned)(lr * DIL) * 1024u + (unsigned)((lane & 7) ^ (lr >> 1)) * 16u, q1 = (unsigned)((8 + lr) * DIL) * 1024u + (unsigned)((lane & 7) ^ (4 + (lr >> 1))) * 16u;
#pragma unroll
      for (int i = 0; i < 4; ++i) glds16s(qb + (long)(8 * (i & ~1)) * DIL * 512, (i & 1) ? q1 : q0, (unsigned)__builtin_amdgcn_readfirstlane(lds0 + LST + wid * 4096 + i * 1024));
      const unsigned kw = (unsigned)(lr * DIL) * 1024u + (unsigned)((lane & 7) ^ ((4 * (wid & 1) + (lr >> 1)) & 7)) * 16u;
      const unsigned vw = (unsigned)(lr * DIL) * 1024u + (unsigned)((lane & 7) ^ (((lr >> 1) & 1) << 2)) * 16u;
      const bf16* kb = T.KA + (rowbase + (long)(a0 - 128 + 8 * wid) * DIL + s) * 512 + h * 64; const bf16* vb = T.VA + (rowbase + (long)(a0 - 128 + 8 * wid) * DIL + s) * 512 + h * 64;
#pragma unroll
      for (int c = 0; c < 6; ++c) if (c >= cmin) {
          glds16s(kb + (long)(64 * c) * DIL * 512, kw, (unsigned)__builtin_amdgcn_readfirstlane(lds0 + LK + (64 * c + 8 * wid) * 128));
          glds16s(vb + (long)(64 * c) * DIL * 512, vw, (unsigned)__builtin_amdgcn_readfirstlane(lds0 + LV + (64 * c + 8 * wid) * 128)); } }
    if (cmin) asm volatile("s_waitcnt vmcnt(8)" ::: "memory"); else asm volatile("s_waitcnt vmcnt(12)" ::: "memory");
    bf16x8 qr[4];
    { const LAS unsigned char* qs = lds + LST + wid * 4096 + r32 * 128;
#pragma unroll
      for (int d0 = 0; d0 < 4; ++d0) qr[d0] = *(const LAS bf16x8*)(qs + (((2 * d0 + hi) ^ ((r32 >> 1) & 7)) * 16)); }
    f32x16 o[2]; o[0] = f32x16{}; o[1] = f32x16{}; float l = 0.f;
    const int ub = r32 - 4 * hi, cpy = (31 - ub) & 3;
    const LAS float* tlane = (const LAS float*)(lds + TB_OFF) + (P * 4 + cpy) * TBC + (31 - ub - cpy);
    const int ksw = (r32 >> 1) & 7;
    const LAS unsigned char* kl = lds + LK + r32 * 128;
    const int vq = (lane & 15) >> 2, vsw = (vq >> 1) & 1;
    const lds_cptr vl = (lds_cptr)lds + LV + (4 * hi + vq) * 128 + ((lane >> 4) & 1) * 32 + (lane & 3) * 8;
    volatile LAS unsigned* cnt = (volatile LAS unsigned*)(lds + CNT_OFF);
#define COMPUTE(jv) do { const int sub = wid + (jv);                   \
        f32x16 pj; { const LAS f32x4* bp = (const LAS f32x4*)(tlane + 32 * (jv)); const f32x4 b0 = bp[0], b1 = bp[2], b2 = bp[4], b3 = bp[6]; \
          pj = (f32x16){b0[0], b0[1], b0[2], b0[3], b1[0], b1[1], b1[2], b1[3], b2[0], b2[1], b2[2], b2[3], b3[0], b3[1], b3[2], b3[3]}; } \
        const LAS unsigned char* ks = kl + sub * 4096; \
        bf16x8 kf[4], vf[2][2]; \
        _Pragma("unroll") for (int d0 = 0; d0 < 4; ++d0) kf[d0] = *(const LAS bf16x8*)(ks + (((2 * d0 + hi) ^ ksw) * 16)); \
        { const lds_cptr vp = vl + sub * 4096; \
          _Pragma("unroll") for (int dh = 0; dh < 2; ++dh) { const lds_cptr vd = vp + ((dh ^ vsw) * 64); const s16x4 l0 = vtr(vd), h0 = vtr(vd + 1024), l1 = vtr(vd + 2048), h1 = vtr(vd + 3072); \
              vf[dh][0] = (bf16x8){l0[0], l0[1], l0[2], l0[3], h0[0], h0[1], h0[2], h0[3]}; vf[dh][1] = (bf16x8){l1[0], l1[1], l1[2], l1[3], h1[0], h1[1], h1[2], h1[3]}; } } \
        _Pragma("unroll") for (int d0 = 0; d0 < 4; ++d0) pj = MFMA32(kf[d0], qr[d0], pj); \
        float sm = 0.f; \
        _Pragma("unroll") for (int r = 0; r < 16; ++r) { pj[r] = __builtin_amdgcn_exp2f(pj[r]); sm += pj[r]; } \
        l += sm; \
        v4u pw0, pw1; \
        _Pragma("unroll") for (int jj = 0; jj < 4; ++jj) { pw0[jj] = pk2(pj[2 * jj], pj[2 * jj + 1]); pw1[jj] = pk2(pj[8 + 2 * jj], pj[8 + 2 * jj + 1]); } \
        _Pragma("unroll") for (int dh = 0; dh < 2; ++dh) { o[dh] = MFMA32(__builtin_bit_cast(bf16x8, pw0), vf[dh][0], o[dh]); o[dh] = MFMA32(__builtin_bit_cast(bf16x8, pw1), vf[dh][1], o[dh]); } } while (0)
    int jn = a0 == 0 ? (wid >= 4 ? 0 : 4 - wid) : 0;
#define CH(c, N) do { if ((c) >= cmin) asm volatile("s_waitcnt vmcnt(" #N ")" ::: "memory"); \
        if (lane == 0) __hip_atomic_fetch_add((LAS unsigned*)(lds + CNT_OFF) + (c), 1u, __ATOMIC_RELAXED, __HIP_MEMORY_SCOPE_WORKGROUP); \
        while (jn <= 4) { const int ck = (wid + jn) >> 1; if (ck > (c) || !chunk_ready(cnt, ck, target)) break; asm volatile("" ::: "memory"); COMPUTE(jn); ++jn; } } while (0)
    CH(0, 10); CH(1, 8); CH(2, 6); CH(3, 4); CH(4, 2); CH(5, 0);
#undef CH
#pragma unroll 1
    while (jn <= 4) { const int ck = (wid + jn) >> 1; while (!chunk_ready(cnt, ck, target)) __builtin_amdgcn_s_sleep(1); asm volatile("" ::: "memory"); COMPUTE(jn); ++jn; }
#undef COMPUTE
    l = half_swap_add(l);
    LAS float* wsf = (LAS float*)(lds + WSF_OFF) + wid * 32;
    LAS float* stg = (LAS float*)(lds + LST + wid * 4096);
    dil4::store_group<DIL, P>(o, l, s, a0 + 32 * wid, rowbase, h, T, stg, wsf, lane);
}
}

namespace dil6 {
using dil4::TBC; using dil4::TB_OFF; using dil4::WSF_OFF; using dil4::glds16s; using dil4::T4;
constexpr int NS = 7, LA = 5, PA = 2, CSLOT = 16384;
constexpr int STG_LO = NS * CSLOT, STG_HI = WSF_OFF + 1024, CNT_OFF = LDSCTL_OFF + 768;
static_assert(STG_LO + 4 * 4096 <= LDSCTL_OFF && STG_HI + 4 * 4096 <= LDS_BYTES, "LDS map");
#define VMW_CASE(i) case i: asm volatile("s_waitcnt vmcnt(" #i ")" ::: "memory"); break;
__device__ __forceinline__ void vm_wait_le(int n) {
    switch (n > 15 ? 15 : n) { VMW_CASE(0) VMW_CASE(1) VMW_CASE(2) VMW_CASE(3) VMW_CASE(4) VMW_CASE(5) VMW_CASE(6) VMW_CASE(7) VMW_CASE(8) VMW_CASE(9) VMW_CASE(10) VMW_CASE(11) VMW_CASE(12) VMW_CASE(13) VMW_CASE(14) VMW_CASE(15) } }
#undef VMW_CASE
__device__ __forceinline__ bool cnt_ge(const volatile LAS unsigned* p, unsigned target) { const unsigned v = (unsigned)__builtin_amdgcn_readfirstlane((int)*p); return (int)(v - target) >= 0; }

template <int DIL, int P>
__device__ __forceinline__ void run(int bh, int s0, int a0r, int& slot, unsigned& occ, const T4 T, LAS unsigned char* lds) {
    const int tid = threadIdx.x; int lane = tid & 63; asm volatile("" : "+v"(lane)); const int wid = __builtin_amdgcn_readfirstlane(tid >> 6);
    const int r32 = lane & 31, hi = lane >> 5, lr = lane >> 3;
    const int b = bh >> 3, h = bh & 7; const long rowbase = (long)b * SEQ;
    const unsigned lds0 = (unsigned)(uintptr_t)lds;
    const int stg_off = wid < 4 ? STG_LO + wid * 4096 : STG_HI + (wid - 4) * 4096;
    const unsigned q0 = (unsigned)(lr * DIL) * 1024u + (unsigned)((lane & 7) ^ (lr >> 1)) * 16u, q1 = (unsigned)((8 + lr) * DIL) * 1024u + (unsigned)((lane & 7) ^ (4 + (lr >> 1))) * 16u;
    const unsigned kw = (unsigned)(lr * DIL) * 1024u + (unsigned)((lane & 7) ^ ((4 * (wid & 1) + (lr >> 1)) & 7)) * 16u;
    const unsigned vw = (unsigned)(lr * DIL) * 1024u + (unsigned)((lane & 7) ^ (((lr >> 1) & 1) << 2)) * 16u;
    const bf16* const kbase = T.KA + rowbase * 512 + h * 64; const bf16* const vbase = T.VA + rowbase * 512 + h * 64; const bf16* const qbase = T.QA + rowbase * 512 + h * 64;
    const int g0 = (P == 2 || a0r == 0) ? 2 : 0;
    volatile LAS unsigned* const rdy = (volatile LAS unsigned*)(lds + CNT_OFF); volatile LAS unsigned* const dne = (volatile LAS unsigned*)(lds + CNT_OFF + 32);
    int D = 0, Dq = 0; unsigned long long hist = 0;
    int ls = slot; unsigned lo = occ;
#define CHUNK_TOK(g) (P == 2 ? (long)(64 * (((g) - 2) & 3) + 8 * wid) * 16 + (s0 + (((g) - 2) >> 2)) : (long)(a0r - 128 + 64 * (g) + 8 * wid) * DIL + s0)
#define ISSUE_CHUNK(g) do { while (!cnt_ge(dne + ls, 8u * lo)) __builtin_amdgcn_s_sleep(1); asm volatile("" ::: "memory"); \
        const long tok_ = CHUNK_TOK(g); const unsigned dst_ = (unsigned)__builtin_amdgcn_readfirstlane(lds0 + ls * CSLOT + wid * 1024); \
        glds16s(kbase + tok_ * 512, kw, dst_); glds16s(vbase + tok_ * 512, vw, dst_ + 8192); D += 2; if (++ls == NS) { ls = 0; ++lo; } } while (0)
#define ISSUE_Q(k) do { const long tok_ = P == 2 ? (long)(32 * wid) * 16 + (s0 + (k)) : (long)(a0r + 256 * (k) + 32 * wid) * DIL + s0; const bf16* qb_ = qbase + tok_ * 512; \
        _Pragma("unroll") for (int i_ = 0; i_ < 4; ++i_) glds16s(qb_ + (long)(8 * (i_ & ~1)) * DIL * 512, (i_ & 1) ? q1 : q0, (unsigned)__builtin_amdgcn_readfirstlane(lds0 + stg_off + i_ * 1024)); D += 4; Dq = D; } while (0)
    ISSUE_Q(0);
#pragma unroll 1
    for (int gl = g0; gl < g0 + LA; ++gl) { ISSUE_CHUNK(gl); hist = (hist << 8) | (unsigned)(D & 255); }
    bf16x8 qr[4], qn[4]; f32x16 o[2]; float l = 0.f;
    qr[0] = qr[1] = qr[2] = qr[3] = bf16x8{}; qn[0] = qn[1] = qn[2] = qn[3] = bf16x8{}; o[0] = f32x16{}; o[1] = f32x16{};
    const int ub = r32 - 4 * hi, cpy = (31 - ub) & 3;
    const LAS float* tlane = (const LAS float*)(lds + TB_OFF) + (P * 4 + cpy) * TBC + (31 - ub - cpy);
    const int ksw = (r32 >> 1) & 7;
    const int vq = (lane & 15) >> 2, vsw = (vq >> 1) & 1;
    const int klane = r32 * 128, vlane = 8192 + (4 * hi + vq) * 128 + ((lane >> 4) & 1) * 32 + (lane & 3) * 8;
#define COMPUTE(jv, par) do { \
        f32x16 pj; { const LAS f32x4* bp = (const LAS f32x4*)(tlane + 32 * (jv)); const f32x4 b0 = bp[0], b1 = bp[2], b2 = bp[4], b3 = bp[6]; \
          pj = (f32x16){b0[0], b0[1], b0[2], b0[3], b1[0], b1[1], b1[2], b1[3], b2[0], b2[1], b2[2], b2[3], b3[0], b3[1], b3[2], b3[3]}; } \
        const LAS unsigned char* ks = lds + slot * CSLOT + (par) * 4096 + klane; \
        bf16x8 kf[4], vf[2][2]; \
        _Pragma("unroll") for (int d0 = 0; d0 < 4; ++d0) kf[d0] = *(const LAS bf16x8*)(ks + (((2 * d0 + hi) ^ ksw) * 16)); \
        { const lds_cptr vp = (lds_cptr)lds + slot * CSLOT + (par) * 4096 + vlane; \
          _Pragma("unroll") for (int dh = 0; dh < 2; ++dh) { const lds_cptr vd = vp + ((dh ^ vsw) * 64); const s16x4 l0 = vtr(vd), h0 = vtr(vd + 1024), l1 = vtr(vd + 2048), h1 = vtr(vd + 3072); \
              vf[dh][0] = (bf16x8){l0[0], l0[1], l0[2], l0[3], h0[0], h0[1], h0[2], h0[3]}; vf[dh][1] = (bf16x8){l1[0], l1[1], l1[2], l1[3], h1[0], h1[1], h1[2], h1[3]}; } } \
        _Pragma("unroll") for (int d0 = 0; d0 < 4; ++d0) pj = MFMA32(kf[d0], qr[d0], pj); \
        float sm = 0.f; \
        _Pragma("unroll") for (int r = 0; r < 16; ++r) { pj[r] = __builtin_amdgcn_exp2f(pj[r]); sm += pj[r]; } \
        l += sm; \
        v4u pw0, pw1; \
        _Pragma("unroll") for (int jj = 0; jj < 4; ++jj) { pw0[jj] = pk2(pj[2 * jj], pj[2 * jj + 1]); pw1[jj] = pk2(pj[8 + 2 * jj], pj[8 + 2 * jj + 1]); } \
        _Pragma("unroll") for (int dh = 0; dh < 2; ++dh) { o[dh] = MFMA32(vf[dh][0], __builtin_bit_cast(bf16x8, pw0), o[dh]); o[dh] = MFMA32(vf[dh][1], __builtin_bit_cast(bf16x8, pw1), o[dh]); } } while (0)
#pragma unroll 1
    for (int g = g0; g < 18; ++g) {
        if (g + LA < 18) ISSUE_CHUNK(g + LA);
        hist = (hist << 8) | (unsigned)(D & 255);
        if (g + PA < 18) {
            vm_wait_le((D - (int)((hist >> (8 * (LA - PA))) & 255)) & 255);
            if (g == g0) {
#pragma unroll
                for (int t = 0; t < PA; ++t) { const int sp = slot + t >= NS ? slot + t - NS : slot + t; if (lane == 0) __hip_atomic_fetch_add((LAS unsigned*)(lds + CNT_OFF) + sp, 1u, __ATOMIC_RELAXED, __HIP_MEMORY_SCOPE_WORKGROUP); } }
            const int sp = slot + PA >= NS ? slot + PA - NS : slot + PA;
            if (lane == 0) __hip_atomic_fetch_add((LAS unsigned*)(lds + CNT_OFF) + sp, 1u, __ATOMIC_RELAXED, __HIP_MEMORY_SCOPE_WORKGROUP);
        }
        const int d = g - (wid >> 1);
        if (d >= 0 && d < 16 && (d & 3) != 3) {
            const int k = d >> 2, m = d & 3, c = g - 4 * k;
            const int jmin = (P == 2 || (a0r == 0 && k == 0)) ? (wid >= 4 ? 0 : 4 - wid) : 0;
            if (m == 0 || g == g0) {
                if (k == 0) {
                    vm_wait_le((D - Dq) & 255);
                    const LAS unsigned char* qs = lds + stg_off + r32 * 128;
#pragma unroll
                    for (int d0 = 0; d0 < 4; ++d0) qr[d0] = *(const LAS bf16x8*)(qs + (((2 * d0 + hi) ^ ((r32 >> 1) & 7)) * 16));
                    asm volatile("s_waitcnt lgkmcnt(0)" ::: "memory");
                } else {
#pragma unroll
                    for (int d0 = 0; d0 < 4; ++d0) qr[d0] = qn[d0];
                }
                o[0] = f32x16{}; o[1] = f32x16{}; l = 0.f;
                if (k < 3) ISSUE_Q(k + 1);
            }
            while (!cnt_ge(rdy + slot, 8u * (occ + 1u))) __builtin_amdgcn_s_sleep(1);
            asm volatile("" ::: "memory");
            const int j0 = 2 * c - wid, j1 = j0 + 1;
            if (j0 >= jmin && j0 >= 0 && j0 <= 4) COMPUTE(j0, 0);
            if (j1 >= jmin && j1 >= 0 && j1 <= 4) COMPUTE(j1, 1);
            if (m == 2) {
                if (k < 3) {
                    vm_wait_le((D - Dq) & 255);
                    const LAS unsigned char* qs = lds + stg_off + r32 * 128;
#pragma unroll
                    for (int d0 = 0; d0 < 4; ++d0) qn[d0] = *(const LAS bf16x8*)(qs + (((2 * d0 + hi) ^ ((r32 >> 1) & 7)) * 16));
                    asm volatile("s_waitcnt lgkmcnt(0)" ::: "memory");
                }
                l = half_swap_add(l);
                const int s_ = P == 2 ? s0 + k : s0, a_ = P == 2 ? 32 * wid : a0r + 256 * k + 32 * wid;
                { LAS unsigned char* const sw = lds + stg_off + r32 * 128 + ((hi ^ (r32 >> 4)) & 1) * 8; const int rsw = (r32 >> 1) & 7;
#pragma unroll
                  for (int dh = 0; dh < 2; ++dh)
#pragma unroll
                      for (int g4 = 0; g4 < 4; ++g4) *(LAS unsigned long long*)(sw + (((dh * 4 + g4) ^ rsw) * 16)) = (unsigned long long)pk2(o[dh][4 * g4], o[dh][4 * g4 + 1]) | ((unsigned long long)pk2(o[dh][4 * g4 + 2], o[dh][4 * g4 + 3]) << 32); }
                asm volatile("s_waitcnt lgkmcnt(0)" ::: "memory");
                bf16* const OPb = (P == 0 ? T.OP0 : P == 1 ? T.OP1 : T.OP2) + h * 64 + (lane & 7) * 8;
#pragma unroll
                for (int it = 0; it < 4; ++it) { const int row = 8 * it + (lane >> 3);
                    const v4u x = *(const LAS v4u*)(lds + stg_off + row * 128 + (((lane & 7) ^ ((row >> 1) & 7)) * 16));
                    const v4u y = it >= 2 ? (v4u){x[2], x[3], x[0], x[1]} : x;
                    const size_t tok = (size_t)(rowbase + (long)(a_ + row) * DIL + s_);
                    asm volatile("global_store_dwordx4 %0, %1, off\n\ts_nop 1" :: "v"(OPb + tok * 512), "v"(y) : "memory"); }
                { const size_t tok = (size_t)(rowbase + (long)(a_ + r32) * DIL + s_);
                  asm volatile("global_store_dword %0, %1, off" :: "v"(T.LP + ((size_t)P * M + tok) * 8 + h), "v"(l) : "memory"); }
                asm volatile("s_waitcnt lgkmcnt(0)" ::: "memory");
            }
        }
        asm volatile("s_waitcnt lgkmcnt(0)" ::: "memory");
        if (lane == 0) __hip_atomic_fetch_add((LAS unsigned*)(lds + CNT_OFF + 32) + slot, 1u, __ATOMIC_RELAXED, __HIP_MEMORY_SCOPE_WORKGROUP);
        if (++slot == NS) { slot = 0; ++occ; }
    }
#undef COMPUTE
#undef ISSUE_Q
#undef ISSUE_CHUNK
#undef CHUNK_TOK
}
}


namespace p2c {
constexpr int WSLOT = 32768, STG = 132096, GT = STG + 8 * 2048;
constexpr int GT_QN = 0, GT_QR = 64, GT_KN = 96;
struct T2 { const bf16 *CQ, *CKV, *WQ, *WKV; const float *SSQ, *GN, *CS; bf16 *QB, *KN, *VB; };
__device__ __forceinline__ void glds16s(const void* sbase, unsigned voff, unsigned lds_base) {
    unsigned sv; asm volatile("s_mov_b32 %0, m0\n\ts_mov_b32 m0, %3\n\ts_nop 0\n\tglobal_load_lds_dwordx4 %1, %2\n\ts_mov_b32 m0, %0" : "=&s"(sv) : "v"(voff), "s"(sbase), "s"(lds_base) : "memory"); }
struct Packed { unsigned w[8]; };
__device__ __forceinline__ void pack_tile(Packed& p, const f32x16& a) {
#pragma unroll
    for (int i = 0; i < 8; ++i) p.w[i] = pk2(a[2 * i], a[2 * i + 1]);
}
__device__ __forceinline__ void flush_tile(const Packed& p, LAS unsigned char* stg, bf16* dst0, int pitch, int lane) {
    const int r32 = lane & 31, hi = lane >> 5;
#pragma unroll
    for (int g = 0; g < 4; ++g) { const int c8 = 2 * g + hi;
        *(LAS unsigned long long*)(stg + r32 * 64 + (((c8 >> 1) ^ (r32 & 3)) * 16) + (c8 & 1) * 8) = (unsigned long long)p.w[2 * g] | ((unsigned long long)p.w[2 * g + 1] << 32); }
    asm volatile("s_waitcnt lgkmcnt(0)" ::: "memory");
#pragma unroll
    for (int i = 0; i < 2; ++i) { const int row = i * 16 + (lane >> 2), ch = lane & 3; const v4u v = *(const LAS v4u*)(stg + row * 64 + ((ch ^ (row & 3)) * 16));
        *(v4u*)(dst0 + (size_t)row * pitch + ch * 8) = v; }
    asm volatile("s_waitcnt lgkmcnt(0)" ::: "memory");
}
__device__ __forceinline__ void unit(int u, const T2 T, LAS unsigned char* lds) {
    int tid = threadIdx.x; asm volatile("" : "+v"(tid));
    const int lane = tid & 63; const int wid = __builtin_amdgcn_readfirstlane(tid >> 6);
    const int r32 = lane & 31, hi = lane >> 5, rg = wid & 3, jh = wid >> 2, h4 = wid & 3;
    const unsigned lds0 = (unsigned)(uintptr_t)lds;
    const size_t tok0 = (size_t)u * 128 + rg * 32, tok = tok0 + r32;
    const int rq0 = 2 * h4 + (lane >> 5), rk0 = 4 * h4 + (lane >> 4);
    const unsigned vq0 = (unsigned)rq0 * 512u + (unsigned)((lane & 31) ^ rq0) * 16u;
    const unsigned vk0 = (unsigned)rk0 * 256u + (unsigned)((lane & 15) ^ rk0) * 16u;
    const unsigned wbuf = lds0 + jh * 2 * WSLOT + h4 * 1024;
#define DMA_Q(s) do { unsigned dst_ = wbuf + ((s) & 1) * WSLOT; const bf16* wb_ = T.WQ + (size_t)(6 * jh + (s)) * 64 * 256; unsigned v_ = vq0; asm volatile("" : "+v"(v_)); \
        _Pragma("unroll 1") for (int i = 0; i < 8; ++i) { glds16s(wb_, v_, (unsigned)__builtin_amdgcn_readfirstlane(dst_)); wb_ += 2048; dst_ += 4096; v_ ^= 128u; } } while (0)
#define DMA_KV(s) do { unsigned dst_ = wbuf + ((s) & 1) * WSLOT; const bf16* wb_ = T.WKV + (size_t)(8 * jh + (s) - 6) * 64 * 128; unsigned v_ = vk0; asm volatile("" : "+v"(v_)); \
        _Pragma("unroll 1") for (int i = 0; i < 4; ++i) { glds16s(wb_, v_, (unsigned)__builtin_amdgcn_readfirstlane(dst_)); wb_ += 2048; dst_ += 4096; } } while (0)
    bf16x8 aq[16];
#pragma unroll
    for (int ks = 0; ks < 16; ++ks) aq[ks] = *(const bf16x8*)(T.CQ + tok * 256 + ks * 16 + hi * 8);
    float rq, rk;
    { const f32x4 s0 = *(const f32x4*)(T.SSQ + tok * 8), s1 = *(const f32x4*)(T.SSQ + tok * 8 + 4);
      rq = rsqrtf(((s0[0] + s0[1]) + (s0[2] + s0[3])) * (1.0f / 256.0f) + EPS); rk = rsqrtf((s1[0] + s1[1]) * (1.0f / 128.0f) + EPS); }
    f32x4 cc[2], sn[2];
#pragma unroll
    for (int g = 0; g < 2; ++g) { cc[g] = *(const f32x4*)(T.CS + tok * 32 + 8 * g + 4 * hi); sn[g] = *(const f32x4*)(T.CS + tok * 32 + 16 + 8 * g + 4 * hi); }
    LAS float* gt = (LAS float*)(lds + GT);
    __syncthreads();
    if (tid < 160) gt[tid] = T.GN[GN_QN + tid];
    asm volatile("s_waitcnt vmcnt(0)" ::: "memory");
    __syncthreads();
    DMA_Q(0); DMA_Q(1);
    LAS unsigned char* stg = lds + STG + wid * 2048;
    const LAS unsigned char* wring = lds + jh * 2 * WSLOT;
    Packed pk0, pk1; bf16 *pd0 = nullptr, *pd1 = nullptr;
#pragma unroll 1
    for (int s = 0; s < 6; ++s) {
        if (s + 1 < 6) asm volatile("s_waitcnt vmcnt(8)" ::: "memory"); else asm volatile("s_waitcnt vmcnt(0)" ::: "memory");
        __builtin_amdgcn_s_barrier(); asm volatile("" ::: "memory");
        if (s > 0) { flush_tile(pk0, stg, pd0, 768, lane); flush_tile(pk1, stg, pd1, 768, lane); }
        const LAS unsigned char* wt = wring + (s & 1) * WSLOT;
        int swz_ = r32 & 15, r32_ = r32; asm volatile("" : "+v"(swz_), "+v"(r32_));
        f32x16 acc0 = f32x16{}, acc1 = f32x16{};
#pragma unroll
        for (int ks = 0; ks < 16; ++ks) { const int co = (((2 * ks + hi) ^ swz_) * 16);
            const bf16x8 w0 = *(const LAS bf16x8*)(wt + r32_ * 512 + co), w1 = *(const LAS bf16x8*)(wt + (r32_ + 32) * 512 + co);
            acc0 = MFMA32(w0, aq[ks], acc0); acc1 = MFMA32(w1, aq[ks], acc1); if ((ks & 3) == 3) __builtin_amdgcn_sched_barrier(0); }
        asm volatile("s_waitcnt lgkmcnt(0)" ::: "memory");
        __builtin_amdgcn_s_barrier(); asm volatile("" ::: "memory");
        const int j = 6 * jh + s;
        if (j < 8) {
            float ss = 0.f;
#pragma unroll
            for (int r = 0; r < 16; ++r) ss += acc0[r] * acc0[r] + acc1[r] * acc1[r];
            ss = half_swap_add(ss) * (rq * rq); const float rs = rsqrtf(ss * (1.0f / 64.0f) + EPS) * (SCALE_B * rq);
#pragma unroll
            for (int g = 0; g < 4; ++g) { const f32x4 g0 = *(const LAS f32x4*)(gt + GT_QN + 8 * g + 4 * hi) * rs, g1 = *(const LAS f32x4*)(gt + GT_QN + 32 + 8 * g + 4 * hi) * rs;
#pragma unroll
                for (int e = 0; e < 4; ++e) { acc0[4 * g + e] *= g0[e]; acc1[4 * g + e] *= g1[e]; } }
            pack_tile(pk0, acc0); pack_tile(pk1, acc1); pd0 = T.QB + tok0 * 768 + j * 96; pd1 = pd0 + 32;
        } else {
#pragma unroll
            for (int nt = 0; nt < 2; ++nt) { f32x16& a = nt ? acc1 : acc0; float ss = 0.f;
#pragma unroll
                for (int r = 0; r < 16; ++r) ss += a[r] * a[r];
                ss = half_swap_add(ss) * (rq * rq); const float rs = rsqrtf(ss * (1.0f / 32.0f) + EPS) * rq;
#pragma unroll
                for (int g = 0; g < 2; ++g) { const f32x4 g1 = *(const LAS f32x4*)(gt + GT_QR + 8 * g + 4 * hi) * rs, g2 = *(const LAS f32x4*)(gt + GT_QR + 16 + 8 * g + 4 * hi) * rs;
#pragma unroll
                    for (int e = 0; e < 4; ++e) { const float t1 = a[4 * g + e] * g1[e], t2 = a[8 + 4 * g + e] * g2[e];
                        a[4 * g + e] = (t1 * cc[g][e] - t2 * sn[g][e]) * SCALE_B; a[8 + 4 * g + e] = (t1 * sn[g][e] + t2 * cc[g][e]) * SCALE_B; } }
                if (nt == 0) { pack_tile(pk0, a); pd0 = T.QB + tok0 * 768 + (2 * (j - 8)) * 96 + 64; } else { pack_tile(pk1, a); pd1 = T.QB + tok0 * 768 + (2 * (j - 8) + 1) * 96 + 64; } }
        }
        if (s + 2 < 6) DMA_Q(s + 2);
    }
    bf16x8 ak[8];
#pragma unroll
    for (int ks = 0; ks < 8; ++ks) ak[ks] = *(const bf16x8*)(T.CKV + tok * 128 + ks * 16 + hi * 8);
    asm volatile("s_waitcnt vmcnt(0)" ::: "memory");
    __builtin_amdgcn_s_barrier(); asm volatile("" ::: "memory");
    DMA_KV(6); DMA_KV(7);
#pragma unroll 1
    for (int s = 6; s < 14; ++s) {
        if (s + 1 < 14) asm volatile("s_waitcnt vmcnt(4)" ::: "memory"); else asm volatile("s_waitcnt vmcnt(0)" ::: "memory");
        __builtin_amdgcn_s_barrier(); asm volatile("" ::: "memory");
        if (s == 6) { flush_tile(pk0, stg, pd0, 768, lane); flush_tile(pk1, stg, pd1, 768, lane); } else { flush_tile(pk0, stg, pd0, 512, lane); flush_tile(pk1, stg, pd1, 512, lane); }
        const LAS unsigned char* wt = wring + (s & 1) * WSLOT;
        int swz_ = r32 & 15, r32_ = r32; asm volatile("" : "+v"(swz_), "+v"(r32_));
        f32x16 acc0 = f32x16{}, acc1 = f32x16{};
#pragma unroll
        for (int ks = 0; ks < 8; ++ks) { const int co = (((2 * ks + hi) ^ swz_) * 16);
            const bf16x8 w0 = *(const LAS bf16x8*)(wt + r32_ * 256 + co), w1 = *(const LAS bf16x8*)(wt + (r32_ + 32) * 256 + co);
            acc0 = MFMA32(w0, ak[ks], acc0); acc1 = MFMA32(w1, ak[ks], acc1); if ((ks & 3) == 3) __builtin_amdgcn_sched_barrier(0); }
        asm volatile("s_waitcnt lgkmcnt(0)" ::: "memory");
        __builtin_amdgcn_s_barrier(); asm volatile("" ::: "memory");
        const int hd = s - 6;
        if (jh == 0) {
            float ss = 0.f;
#pragma unroll
            for (int r = 0; r < 16; ++r) ss += acc0[r] * acc0[r] + acc1[r] * acc1[r];
            ss = half_swap_add(ss) * (rk * rk); const float rs = rsqrtf(ss * (1.0f / 64.0f) + EPS) * rk;
#pragma unroll
            for (int g = 0; g < 4; ++g) { const f32x4 g0 = *(const LAS f32x4*)(gt + GT_KN + 8 * g + 4 * hi) * rs, g1 = *(const LAS f32x4*)(gt + GT_KN + 32 + 8 * g + 4 * hi) * rs;
#pragma unroll
                for (int e = 0; e < 4; ++e) { acc0[4 * g + e] *= g0[e]; acc1[4 * g + e] *= g1[e]; } }
        } else {
#pragma unroll
            for (int r = 0; r < 16; ++r) { acc0[r] *= rk; acc1[r] *= rk; }
        }
        pack_tile(pk0, acc0); pack_tile(pk1, acc1); pd0 = (jh == 0 ? T.KN : T.VB) + tok0 * 512 + hd * 64; pd1 = pd0 + 32;
        if (s + 2 < 14) DMA_KV(s + 2);
    }
    flush_tile(pk0, stg, pd0, 512, lane); flush_tile(pk1, stg, pd1, 512, lane);
#undef DMA_Q
#undef DMA_KV
}
}

struct Args { const void* in[18]; float* out; unsigned char* ws; int ph_lo, ph_hi, li, pad; };
constexpr int PER_PHASE = 6;
#ifndef MK_N_LAUNCHES
#define MK_N_LAUNCHES 1
#endif
constexpr int N_LAUNCHES = MK_N_LAUNCHES;

__global__ void __launch_bounds__(NWAVES * 64, 2) hybrid_fwd(Args args) {
    extern __shared__ __attribute__((aligned(16))) unsigned char lds[];
    Frame F;
    F.lds = (LAS unsigned char*)lds;
    F.MISC = (volatile LAS unsigned*)(F.lds + MISC_OFF);
    F.tid = threadIdx.x; F.lane = F.tid & 63; F.wave = __builtin_amdgcn_readfirstlane(F.tid >> 6);
    F.G = gridDim.x; { const int bx = blockIdx.x; F.vcu = (F.G % 8 == 0) ? (bx % 8) * (F.G / 8) + bx / 8 : bx; }
    unsigned char* const ws = args.ws;
    F.ctl = (gu32*)(ws + WS_CTL);
#define INF(i) ((const float*)args.in[i])
#define WSB(off) ((bf16*)(ws + (off)))
#define WSF(off) ((float*)(ws + (off)))
    for (int u = F.tid; u < (LDS_BYTES - LDSCTL_OFF) / 4; u += NWAVES * 64) ((LAS unsigned*)(F.lds + LDSCTL_OFF))[u] = 0u;
    __syncthreads();
    XcdBarrier bar; bar.bar = (unsigned*)(F.ctl + CW_BAR); bar.x = 0; bar.st = nullptr;
    if (N_LAUNCHES != PER_PHASE) bar = xcd_barrier_post((unsigned*)(F.ctl + CW_BAR), F.MISC + 8);
#define GRID_BAR() do { if (N_LAUNCHES == PER_PHASE) { if (F.tid == 0) __hip_atomic_store(F.ctl + CW_TMO, 0xBADBA0u, RLX_AGENT); } else { xcd_barrier(bar); } } while (0)
    const int lo = args.ph_lo, hi_ = args.ph_hi;
#define IN(k) (lo <= (k) && (k) < hi_)
#define BOTH(k) (IN(k) && IN((k) + 1))

    if (IN(0)) {
        ProIn P{INF(0), INF(2), INF(3), INF(4), INF(7), INF(8), INF(9), INF(10), INF(15), (const int*)args.in[1], WSB(WS_WIN), WSB(WS_WUQ), WSB(WS_WUKV), WSB(WS_WOUT), WSB(WS_XN), WSF(WS_CS), WSF(WS_BT), INF(5), INF(6), INF(11), INF(12), INF(13), INF(14), WSF(WS_GN)};
        p0_prologue(F, P); if (BOTH(0)) GRID_BAR(); }

    if (IN(1)) {
        pg8::Gemm g{WSB(WS_XN), WSB(WS_WIN), M, NIN, DMODEL}; pg8::StaticOrder S; S.init(M, NIN, F.G, (int)blockIdx.x);
        EpiP1 E{ws};
        pg8::gemm_phase<EpiP1, pg8::StaticOrder, true, true>(F.lds + RING_OFF, g, S, E);
        if (BOTH(1)) GRID_BAR();
    }
    if (IN(2)) {
        const p2c::T2 T{WSB(WS_CQ), WSB(WS_CKV), WSB(WS_WUQ), WSB(WS_WUKV), WSF(WS_SSQ), WSF(WS_GN), WSF(WS_CS), WSB(WS_QB), WSB(WS_KN), WSB(WS_VB)};
        for (int u = F.vcu; u < M / 128; u += F.G) p2c::unit(u, T, F.lds);
        __syncthreads();
        if (BOTH(2)) GRID_BAR();
    }
    if (IN(3)) {
        {
            const MlaT T{WSB(WS_QB), WSB(WS_KN), WSB(WS_KR), WSB(WS_VB), WSB(WS_SZ), WSB(WS_MIX)};
            for (int uidx = F.vcu; uidx < 1024; uidx += F.G) {
                int bh, qb;
                if (F.G == 256) { const int r = uidx >> 8, x = F.vcu >> 5, i = F.vcu & 31, c16 = i & 15; bh = 8 * x + 2 * r + (i >> 4); qb = (r & 1) ? 15 - c16 : c16; }
                else { bh = uidx >> 4; qb = uidx & 15; }
                mla2::unit(bh >> 3, bh & 7, qb, T, (char*)lds);
            }
        }
        __syncthreads();
        {
            const dil4::T4 T4{WSB(WS_QA), WSB(WS_KA), WSB(WS_VA), WSB(WS_OP0), WSB(WS_OP1), WSB(WS_OP2), WSF(WS_LP), WSF(WS_BT)};
            const float* BT = WSF(WS_BT);
            const bool loc = (F.G == 256); const int x = F.vcu >> 5, i = F.vcu & 31;
            int cur_h = -1; int slot = 0; unsigned occ = 0;
            const int nrounds = loc ? 3 : (768 + F.G - 1) / F.G;
#pragma unroll 1
            for (int n = 0; n < nrounds; ++n) {
                int bh, rr;
                if (loc) { const int idx = n * 32 + i, bsel = idx / 12; rr = idx - 12 * bsel; bh = 8 * bsel + x; }
                else { const int u = n * F.G + F.vcu; bh = u / 12; rr = u % 12; if (u >= 768) bh = -1; }
                const int h_ = bh & 7;
                if (h_ != cur_h || !loc) { __syncthreads(); if (bh >= 0) dil4::build_tables(BT, h_, F.lds); __syncthreads(); cur_h = h_; }
                if (bh >= 0) { const int p_ = rr >> 2, q_ = rr & 3;
                    if (p_ == 0) dil6::run<1, 0>(bh, 0, 1024 * q_, slot, occ, T4, F.lds); else if (p_ == 1) dil6::run<4, 1>(bh, q_, 0, slot, occ, T4, F.lds); else dil6::run<16, 2>(bh, 4 * q_, 0, slot, occ, T4, F.lds); }
            }
        }
        if (BOTH(3)) GRID_BAR();
    }
    if (IN(4)) {
        const bf16 *OP0 = WSB(WS_OP0), *OP1 = WSB(WS_OP1), *OP2 = WSB(WS_OP2), *SZ = WSB(WS_SZ); bf16* MIX = WSB(WS_MIX); const float* LP = WSF(WS_LP);
        const int gt = F.vcu * (NWAVES * 64) + F.tid, NGT = F.G * NWAVES * 64;
        for (int e = gt; e < M * 64; e += NGT) { const int row = e >> 6, c8 = (e & 63) * 8, h = c8 >> 6;
            const size_t off = (size_t)row * 512 + c8;
            const v4u a = *(const v4u*)(OP0 + off), b2 = *(const v4u*)(OP1 + off), c = *(const v4u*)(OP2 + off), z = *(const v4u*)(SZ + (size_t)row * 1024 + c8);
            const float lt = LP[((size_t)0 * M + row) * 8 + h] + LP[((size_t)1 * M + row) * 8 + h] + LP[((size_t)2 * M + row) * 8 + h]; const float rl = 1.0f / lt;
            v4u o;
#pragma unroll
            for (int k = 0; k < 4; ++k) { const float lo_ = (bflo(a[k]) + bflo(b2[k]) + bflo(c[k])) * rl * bflo(z[k]), hi2 = (bfhi(a[k]) + bfhi(b2[k]) + bfhi(c[k])) * rl * bfhi(z[k]); o[k] = pk2(lo_, hi2); }
            *(v4u*)(MIX + (size_t)row * 1024 + c8) = o; }
        if (BOTH(4)) GRID_BAR();
    }
    if (IN(5)) {
        pg8::Gemm g{WSB(WS_MIX), WSB(WS_WOUT), M, DMODEL, DMODEL}; pg8::StaticOrder S; S.init(M, DMODEL, F.G, (int)blockIdx.x);
        EpiOut E{INF(0), args.out};
        pg8::gemm_phase<EpiOut, pg8::StaticOrder, true, true>(F.lds + RING_OFF, g, S, E);
    }
#undef IN
#undef BOTH
}

extern "C" void kernel_launch(void* const* d_in, const int* in_sizes, int n_in, void* d_out, int out_size, void* d_ws, size_t ws_size, hipStream_t stream) {
    static int grid = 0;
    if (grid == 0) {
        if (n_in != 16 || in_sizes[0] != M * DMODEL || out_size != M * DMODEL || ws_size < WS_END) { fprintf(stderr, "kernel_launch: unexpected shapes (n_in %d, in0 %d, out %d, ws %zu)\n", n_in, n_in > 0 ? in_sizes[0] : -1, out_size, ws_size); grid = -1; return; }
        int dev = 0, cus = 0, per_cu = 0;
        if (hipGetDevice(&dev) != hipSuccess || hipDeviceGetAttribute(&cus, hipDeviceAttributeMultiprocessorCount, dev) != hipSuccess) { grid = -1; return; }
        if (hipFuncSetAttribute((const void*)hybrid_fwd, hipFuncAttributeMaxDynamicSharedMemorySize, LDS_BYTES) != hipSuccess) { fprintf(stderr, "kernel_launch: hipFuncSetAttribute failed\n"); grid = -1; return; }
        if (hipOccupancyMaxActiveBlocksPerMultiprocessor(&per_cu, (const void*)hybrid_fwd, NWAVES * 64, LDS_BYTES) != hipSuccess || per_cu < 1) { fprintf(stderr, "kernel_launch: occupancy query says %d blocks per CU\n", per_cu); (void)hipGetLastError(); grid = -1; return; }
        grid = cus;
    }
    if (grid < 0) return;
    (void)hipMemsetAsync((char*)d_ws + WS_CTL, 0, CTL_ZERO_BYTES, stream);
    Args a{};
    for (int i = 0; i < 16; ++i) a.in[i] = d_in[i];
    a.out = (float*)d_out; a.ws = (unsigned char*)d_ws;
    for (int li = 0; li < N_LAUNCHES; ++li) {
        if (N_LAUNCHES == PER_PHASE) { a.ph_lo = li; a.ph_hi = li + 1; } else { a.ph_lo = 0; a.ph_hi = PER_PHASE; }
        a.li = li;
        hipLaunchKernelGGL(hybrid_fwd, dim3(grid), dim3(NWAVES * 64), LDS_BYTES, stream, a);
    }
}
```

```cpp
#include <hip/hip_runtime.h>
#include <cstdio>
#include <cstdint>
#include <cmath>
namespace pg8 {
#define PG8_LAS __attribute__((address_space(3)))
typedef unsigned short bf16_t;
typedef short bf16x8 __attribute__((ext_vector_type(8)));
typedef float f32x4 __attribute__((ext_vector_type(4)));
typedef unsigned u32x4 __attribute__((ext_vector_type(4)));
constexpr int BM = 256, BK = 64, HALF = 128, HTB = HALF * BK * 2  , STAGE_BYTES = 8 * HTB, NXCD = 8, WGM = 8;

__host__ __device__ __forceinline__ int lds_byte(int r, int c) { const int st = (r >> 4) * 2 + (c >> 5), rr = r & 15, cc = c & 31, ob = rr * 64 + cc * 2; return st * 1024 + (ob ^ (((ob >> 9) & 1) << 5)); }
__host__ __device__ __forceinline__ void stage_rc(int b, int& R, int& C) { const int st = b / 1024, sb = b % 1024, swz = sb ^ (((sb >> 9) & 1) << 5); R = (st >> 1) * 16 + swz / 64; C = (st & 1) * 32 + (swz % 64) / 2; }
__host__ __device__ __forceinline__ int perm32(int rho) { const int n = rho >> 4, i = rho & 15; return 8 * (i >> 2) + 4 * n + (i & 3); }

struct Unit { int pm, pn; };
struct Gemm { const bf16_t* A; const bf16_t* Bt; int M, N, K; };

struct StaticOrder {
    int nM, nN, nwg, G, c;
    __host__ __device__ void init(int M, int N, int G_, int c_) { nM = M / BM; nN = N / BM; nwg = nM * nN; G = G_; c = c_; }
    __host__ __device__ bool next(int i, Unit& u) const {
        const long L = (long)i * G + c; if (L >= nwg) return false;
        int wgid = (int)L; { const int q = nwg / NXCD, r = nwg % NXCD, xcd = wgid % NXCD, off = wgid / NXCD; wgid = (xcd < r ? xcd * (q + 1) : r * (q + 1) + (xcd - r) * q) + off; }
        const int nig = WGM * nN, gid = wgid / nig, fm = gid * WGM, gsz = (nM - fm) < WGM ? (nM - fm) : WGM;
        u.pm = fm + ((wgid % nig) % gsz); u.pn = (wgid % nig) / gsz; return true;
    }
    __device__ __forceinline__ void a_ready(const Unit&) const {}
    __device__ __forceinline__ void done(const Unit&) const {}
};


template <class Epi, class Sched, bool ALIGN_EPI = false, bool SP2 = false>
__device__ __forceinline__ void gemm_phase(PG8_LAS unsigned char* lds, const Gemm g, const Sched& S, const Epi& E) {
    int tid_ = threadIdx.x; asm volatile("" : "+v"(tid_));
    const int tid = tid_, wid = __builtin_amdgcn_readfirstlane(tid >> 6), lane = tid & 63, wr = wid >> 2, wc = wid & 3, fr = lane & 15, fq = lane >> 4;
    const int K = g.K, nt = K / BK;
    unsigned voffA[2], voffB[2];
#pragma unroll
    for (int i = 0; i < 2; ++i) { int R, C; stage_rc(tid * 16 + i * 8192, R, C); const int Rb = Epi::PERM ? ((R & ~31) + perm32(R & 31)) : R;
        voffA[i] = (unsigned)(R * K + C) * 2u; voffB[i] = (unsigned)(Rb * K + C) * 2u; }
    const size_t kstep = (size_t)(BK * 2);
    const size_t hstep = (size_t)HALF * K * 2;
    const size_t tstep = 2 * hstep;
    const unsigned ldsw = (unsigned)wid * 1024u;
    const int aoff = lds_byte(wr * 64 + fr, fq * 8), boff = lds_byte(wc * 32 + fr, fq * 8);
#define PG8_SA(b, h) (((b) * 2 + (h)) * HTB)
#define PG8_SB(b, h) ((4 + (b) * 2 + (h)) * HTB)
#define PG8_STAGE(bufoff, gbase, voff) do { _Pragma("unroll") for (int _i = 0; _i < 2; ++_i) \
        __builtin_amdgcn_global_load_lds((const unsigned*)((const char*)(gbase) + (voff)[_i]), (PG8_LAS unsigned*)(lds + (bufoff) + ldsw + _i * 8192), 16, 0, 0); } while (0)
#define PG8_LDA(dst, b, h) do { _Pragma("unroll") for (int m = 0; m < 4; ++m) _Pragma("unroll") for (int k = 0; k < 2; ++k) dst[m][k] = *(const PG8_LAS bf16x8*)(lds + PG8_SA(b, h) + aoff + m * 2048 + k * 1024); } while (0)
#define PG8_LDB(dst, b, h) do { _Pragma("unroll") for (int n = 0; n < 2; ++n) _Pragma("unroll") for (int k = 0; k < 2; ++k) dst[n][k] = *(const PG8_LAS bf16x8*)(lds + PG8_SB(b, h) + boff + n * 2048 + k * 1024); } while (0)
#define PG8_MMA(ai, bj, At, Bt) do { __builtin_amdgcn_s_setprio(1); _Pragma("unroll") for (int m = 0; m < 4; ++m) _Pragma("unroll") for (int n = 0; n < 2; ++n) _Pragma("unroll") for (int k = 0; k < 2; ++k) \
        acc[ai][bj][m][n] = __builtin_amdgcn_mfma_f32_16x16x32_bf16(Bt[n][k], At[m][k], acc[ai][bj][m][n], 0, 0, 0); __builtin_amdgcn_s_setprio(0); } while (0)
#define PG8_WAIT_V(n) asm volatile("s_waitcnt vmcnt(" #n ")" ::: "memory")
#define PG8_WAIT_L(n) asm volatile("s_waitcnt lgkmcnt(" #n ")" ::: "memory")
#define PG8_WAIT_VX do { if constexpr (Epi::XFOLD) PG8_WAIT_V(9); else PG8_WAIT_V(8); } while (0)
#define PG8_XISSUE(k) do { if constexpr (Epi::XFOLD) { const int k_ = (k); const char* xs_ = (k_ < 32 ? xcur : xnxt) + E.xchunk_off(k_ & 31, lane); \
        __builtin_amdgcn_global_load_lds((const unsigned*)xs_, (PG8_LAS unsigned*)(lds + 132096 + wid * 2048 + (k_ & 1) * 1024), 16, 0, 0); } } while (0)
#define PG8_XFOLD(k) do { if constexpr (Epi::XFOLD) { constexpr int k_ = (k); const f32x4 xv_ = *(const PG8_LAS f32x4*)(lds + 132096 + wid * 2048 + (k_ & 1) * 1024 + xrd); \
        acc[k_ >> 4][(k_ >> 1) & 1][(k_ >> 2) & 3][k_ & 1] += xv_; } } while (0)
#define PG8_BAR __builtin_amdgcn_s_barrier()
#define PG8_SCHED __builtin_amdgcn_sched_barrier(0)
    Unit cur, nxt; int ui = 0;
    if (!S.next(0, cur)) return;
    f32x4 acc[2][2][4][2];
#pragma unroll
    for (int a = 0; a < 2; ++a)
#pragma unroll
        for (int b = 0; b < 2; ++b)
#pragma unroll
            for (int m = 0; m < 4; ++m)
#pragma unroll
                for (int n = 0; n < 2; ++n) acc[a][b][m][n] = (f32x4){0.f, 0.f, 0.f, 0.f};
    if constexpr (Epi::INIT) E.init(acc, cur, wr, wc, fr, fq);
    bf16x8 At[4][2], B0[2][2], B1[2][2];
    int xrd = 0; if constexpr (Epi::XFOLD) { xrd = E.xread_off(fr, fq); const char* xcur = E.xtile(cur, wr, wc); const char* xnxt = xcur; PG8_XISSUE(0); }
    const char* cA = (const char*)g.A + (size_t)cur.pm * tstep; const char* cB = (const char*)g.Bt + (size_t)cur.pn * tstep;
    S.a_ready(cur);
    if constexpr (SP2) {
        PG8_STAGE(PG8_SB(0, 0), cB, voffB); PG8_STAGE(PG8_SB(0, 1), cB + hstep, voffB); PG8_STAGE(PG8_SA(0, 0), cA, voffA); PG8_STAGE(PG8_SA(0, 1), cA + hstep, voffA);
        if (wr == 1) PG8_BAR;
        PG8_WAIT_V(2); PG8_BAR;
        PG8_STAGE(PG8_SB(1, 0), cB + kstep, voffB); PG8_STAGE(PG8_SA(1, 0), cA + kstep, voffA); PG8_STAGE(PG8_SB(1, 1), cB + hstep + kstep, voffB);
        PG8_WAIT_V(6); PG8_BAR;
    } else {
        PG8_STAGE(PG8_SB(0, 0), cB, voffB); PG8_STAGE(PG8_SA(0, 0), cA, voffA); PG8_STAGE(PG8_SB(0, 1), cB + hstep, voffB); PG8_STAGE(PG8_SA(0, 1), cA + hstep, voffA);
        if (wr == 1) PG8_BAR;
        PG8_WAIT_V(4); PG8_BAR;
        PG8_STAGE(PG8_SB(1, 0), cB + kstep, voffB); PG8_STAGE(PG8_SA(1, 0), cA + kstep, voffA); PG8_STAGE(PG8_SB(1, 1), cB + hstep + kstep, voffB);
        PG8_WAIT_V(6); PG8_BAR;
    }
    for (;;) {
        const bool has_next = S.next(ui + 1, nxt);
        const char* nA = has_next ? (const char*)g.A + (size_t)nxt.pm * tstep : cA; const char* nB = has_next ? (const char*)g.Bt + (size_t)nxt.pn * tstep : cB;
        if constexpr (SP2 && Epi::XFOLD) {
            const char* xcur = E.xtile(cur, wr, wc); const char* xnxt = E.xtile(has_next ? nxt : cur, wr, wc);
        { constexpr int t = 0;
            const bool last = (t == nt - 2);
            const char* a1 = cA + (size_t)(t + 1) * kstep;
            const char* a2 = last ? nA : cA + (size_t)(t + 2) * kstep; const char* b2 = last ? nB : cB + (size_t)(t + 2) * kstep;
            const char* a3 = a2 + kstep; const char* b3 = b2 + kstep;
            if (last && has_next) S.a_ready(nxt);
            PG8_XISSUE(2 * (0) + 1); PG8_LDB(B0, 0, 0); PG8_LDB(B1, 0, 1); PG8_SCHED; PG8_LDA(At, 0, 0); PG8_STAGE(PG8_SA(1, 1), a1 + hstep, voffA);
            PG8_WAIT_VX; PG8_XFOLD(2 * (0)); PG8_WAIT_L(0); PG8_BAR; PG8_MMA(0, 0, At, B0); PG8_MMA(0, 1, At, B1); PG8_BAR; PG8_SCHED;
            PG8_XISSUE(2 * (0) + 2); PG8_LDA(At, 0, 1); PG8_STAGE(PG8_SB(0, 0), b2, voffB); PG8_STAGE(PG8_SB(0, 1), b2 + hstep, voffB); PG8_STAGE(PG8_SA(0, 0), a2, voffA);
            PG8_WAIT_VX; PG8_XFOLD(2 * (0) + 1); PG8_WAIT_L(0); PG8_BAR; PG8_MMA(1, 0, At, B0); PG8_MMA(1, 1, At, B1); PG8_BAR; PG8_SCHED;
            PG8_XISSUE(2 * (0) + 3); PG8_LDB(B0, 1, 0); PG8_LDB(B1, 1, 1); PG8_SCHED; PG8_LDA(At, 1, 0); PG8_STAGE(PG8_SA(0, 1), a2 + hstep, voffA);
            PG8_WAIT_VX; PG8_XFOLD(2 * (0) + 2); PG8_WAIT_L(0); PG8_BAR; PG8_MMA(0, 0, At, B0); PG8_MMA(0, 1, At, B1); PG8_BAR; PG8_SCHED;
            PG8_XISSUE(2 * (0) + 4); PG8_LDA(At, 1, 1); PG8_STAGE(PG8_SB(1, 0), b3, voffB); PG8_STAGE(PG8_SB(1, 1), b3 + hstep, voffB); PG8_STAGE(PG8_SA(1, 0), a3, voffA);
            PG8_WAIT_VX; PG8_XFOLD(2 * (0) + 3); PG8_WAIT_L(0); PG8_BAR; PG8_MMA(1, 0, At, B0); PG8_MMA(1, 1, At, B1); PG8_BAR; PG8_SCHED;
        }
        { constexpr int t = 2;
            const bool last = (t == nt - 2);
            const char* a1 = cA + (size_t)(t + 1) * kstep;
            const char* a2 = last ? nA : cA + (size_t)(t + 2) * kstep; const char* b2 = last ? nB : cB + (size_t)(t + 2) * kstep;
            const char* a3 = a2 + kstep; const char* b3 = b2 + kstep;
            if (last && has_next) S.a_ready(nxt);
            PG8_XISSUE(2 * (2) + 1); PG8_LDB(B0, 0, 0); PG8_LDB(B1, 0, 1); PG8_SCHED; PG8_LDA(At, 0, 0); PG8_STAGE(PG8_SA(1, 1), a1 + hstep, voffA);
            PG8_WAIT_VX; PG8_XFOLD(2 * (2)); PG8_WAIT_L(0); PG8_BAR; PG8_MMA(0, 0, At, B0); PG8_MMA(0, 1, At, B1); PG8_BAR; PG8_SCHED;
            PG8_XISSUE(2 * (2) + 2); PG8_LDA(At, 0, 1); PG8_STAGE(PG8_SB(0, 0), b2, voffB); PG8_STAGE(PG8_SB(0, 1), b2 + hstep, voffB); PG8_STAGE(PG8_SA(0, 0), a2, voffA);
            PG8_WAIT_VX; PG8_XFOLD(2 * (2) + 1); PG8_WAIT_L(0); PG8_BAR; PG8_MMA(1, 0, At, B0); PG8_MMA(1, 1, At, B1); PG8_BAR; PG8_SCHED;
            PG8_XISSUE(2 * (2) + 3); PG8_LDB(B0, 1, 0); PG8_LDB(B1, 1, 1); PG8_SCHED; PG8_LDA(At, 1, 0); PG8_STAGE(PG8_SA(0, 1), a2 + hstep, voffA);
            PG8_WAIT_VX; PG8_XFOLD(2 * (2) + 2); PG8_WAIT_L(0); PG8_BAR; PG8_MMA(0, 0, At, B0); PG8_MMA(0, 1, At, B1); PG8_BAR; PG8_SCHED;
            PG8_XISSUE(2 * (2) + 4); PG8_LDA(At, 1, 1); PG8_STAGE(PG8_SB(1, 0), b3, voffB); PG8_STAGE(PG8_SB(1, 1), b3 + hstep, voffB); PG8_STAGE(PG8_SA(1, 0), a3, voffA);
            PG8_WAIT_VX; PG8_XFOLD(2 * (2) + 3); PG8_WAIT_L(0); PG8_BAR; PG8_MMA(1, 0, At, B0); PG8_MMA(1, 1, At, B1); PG8_BAR; PG8_SCHED;
        }
        { constexpr int t = 4;
            const bool last = (t == nt - 2);
            const char* a1 = cA + (size_t)(t + 1) * kstep;
            const char* a2 = last ? nA : cA + (size_t)(t + 2) * kstep; const char* b2 = last ? nB : cB + (size_t)(t + 2) * kstep;
            const char* a3 = a2 + kstep; const char* b3 = b2 + kstep;
            if (last && has_next) S.a_ready(nxt);
            PG8_XISSUE(2 * (4) + 1); PG8_LDB(B0, 0, 0); PG8_LDB(B1, 0, 1); PG8_SCHED; PG8_LDA(At, 0, 0); PG8_STAGE(PG8_SA(1, 1), a1 + hstep, voffA);
            PG8_WAIT_VX; PG8_XFOLD(2 * (4)); PG8_WAIT_L(0); PG8_BAR; PG8_MMA(0, 0, At, B0); PG8_MMA(0, 1, At, B1); PG8_BAR; PG8_SCHED;
            PG8_XISSUE(2 * (4) + 2); PG8_LDA(At, 0, 1); PG8_STAGE(PG8_SB(0, 0), b2, voffB); PG8_STAGE(PG8_SB(0, 1), b2 + hstep, voffB); PG8_STAGE(PG8_SA(0, 0), a2, voffA);
            PG8_WAIT_VX; PG8_XFOLD(2 * (4) + 1); PG8_WAIT_L(0); PG8_BAR; PG8_MMA(1, 0, At, B0); PG8_MMA(1, 1, At, B1); PG8_BAR; PG8_SCHED;
            PG8_XISSUE(2 * (4) + 3); PG8_LDB(B0, 1, 0); PG8_LDB(B1, 1, 1); PG8_SCHED; PG8_LDA(At, 1, 0); PG8_STAGE(PG8_SA(0, 1), a2 + hstep, voffA);
            PG8_WAIT_VX; PG8_XFOLD(2 * (4) + 2); PG8_WAIT_L(0); PG8_BAR; PG8_MMA(0, 0, At, B0); PG8_MMA(0, 1, At, B1); PG8_BAR; PG8_SCHED;
            PG8_XISSUE(2 * (4) + 4); PG8_LDA(At, 1, 1); PG8_STAGE(PG8_SB(1, 0), b3, voffB); PG8_STAGE(PG8_SB(1, 1), b3 + hstep, voffB); PG8_STAGE(PG8_SA(1, 0), a3, voffA);
            PG8_WAIT_VX; PG8_XFOLD(2 * (4) + 3); PG8_WAIT_L(0); PG8_BAR; PG8_MMA(1, 0, At, B0); PG8_MMA(1, 1, At, B1); PG8_BAR; PG8_SCHED;
        }
        { constexpr int t = 6;
            const bool last = (t == nt - 2);
            const char* a1 = cA + (size_t)(t + 1) * kstep;
            const char* a2 = last ? nA : cA + (size_t)(t + 2) * kstep; const char* b2 = last ? nB : cB + (size_t)(t + 2) * kstep;
            const char* a3 = a2 + kstep; const char* b3 = b2 + kstep;
            if (last && has_next) S.a_ready(nxt);
            PG8_XISSUE(2 * (6) + 1); PG8_LDB(B0, 0, 0); PG8_LDB(B1, 0, 1); PG8_SCHED; PG8_LDA(At, 0, 0); PG8_STAGE(PG8_SA(1, 1), a1 + hstep, voffA);
            PG8_WAIT_VX; PG8_XFOLD(2 * (6)); PG8_WAIT_L(0); PG8_BAR; PG8_MMA(0, 0, At, B0); PG8_MMA(0, 1, At, B1); PG8_BAR; PG8_SCHED;
            PG8_XISSUE(2 * (6) + 2); PG8_LDA(At, 0, 1); PG8_STAGE(PG8_SB(0, 0), b2, voffB); PG8_STAGE(PG8_SB(0, 1), b2 + hstep, voffB); PG8_STAGE(PG8_SA(0, 0), a2, voffA);
            PG8_WAIT_VX; PG8_XFOLD(2 * (6) + 1); PG8_WAIT_L(0); PG8_BAR; PG8_MMA(1, 0, At, B0); PG8_MMA(1, 1, At, B1); PG8_BAR; PG8_SCHED;
            PG8_XISSUE(2 * (6) + 3); PG8_LDB(B0, 1, 0); PG8_LDB(B1, 1, 1); PG8_SCHED; PG8_LDA(At, 1, 0); PG8_STAGE(PG8_SA(0, 1), a2 + hstep, voffA);
            PG8_WAIT_VX; PG8_XFOLD(2 * (6) + 2); PG8_WAIT_L(0); PG8_BAR; PG8_MMA(0, 0, At, B0); PG8_MMA(0, 1, At, B1); PG8_BAR; PG8_SCHED;
            PG8_XISSUE(2 * (6) + 4); PG8_LDA(At, 1, 1); PG8_STAGE(PG8_SB(1, 0), b3, voffB); PG8_STAGE(PG8_SB(1, 1), b3 + hstep, voffB); PG8_STAGE(PG8_SA(1, 0), a3, voffA);
            PG8_WAIT_VX; PG8_XFOLD(2 * (6) + 3); PG8_WAIT_L(0); PG8_BAR; PG8_MMA(1, 0, At, B0); PG8_MMA(1, 1, At, B1); PG8_BAR; PG8_SCHED;
        }
        { constexpr int t = 8;
            const bool last = (t == nt - 2);
            const char* a1 = cA + (size_t)(t + 1) * kstep;
            const char* a2 = last ? nA : cA + (size_t)(t + 2) * kstep; const char* b2 = last ? nB : cB + (size_t)(t + 2) * kstep;
            const char* a3 = a2 + kstep; const char* b3 = b2 + kstep;
            if (last && has_next) S.a_ready(nxt);
            PG8_XISSUE(2 * (8) + 1); PG8_LDB(B0, 0, 0); PG8_LDB(B1, 0, 1); PG8_SCHED; PG8_LDA(At, 0, 0); PG8_STAGE(PG8_SA(1, 1), a1 + hstep, voffA);
            PG8_WAIT_VX; PG8_XFOLD(2 * (8)); PG8_WAIT_L(0); PG8_BAR; PG8_MMA(0, 0, At, B0); PG8_MMA(0, 1, At, B1); PG8_BAR; PG8_SCHED;
            PG8_XISSUE(2 * (8) + 2); PG8_LDA(At, 0, 1); PG8_STAGE(PG8_SB(0, 0), b2, voffB); PG8_STAGE(PG8_SB(0, 1), b2 + hstep, voffB); PG8_STAGE(PG8_SA(0, 0), a2, voffA);
            PG8_WAIT_VX; PG8_XFOLD(2 * (8) + 1); PG8_WAIT_L(0); PG8_BAR; PG8_MMA(1, 0, At, B0); PG8_MMA(1, 1, At, B1); PG8_BAR; PG8_SCHED;
            PG8_XISSUE(2 * (8) + 3); PG8_LDB(B0, 1, 0); PG8_LDB(B1, 1, 1); PG8_SCHED; PG8_LDA(At, 1, 0); PG8_STAGE(PG8_SA(0, 1), a2 + hstep, voffA);
            PG8_WAIT_VX; PG8_XFOLD(2 * (8) + 2); PG8_WAIT_L(0); PG8_BAR; PG8_MMA(0, 0, At, B0); PG8_MMA(0, 1, At, B1); PG8_BAR; PG8_SCHED;
            PG8_XISSUE(2 * (8) + 4); PG8_LDA(At, 1, 1); PG8_STAGE(PG8_SB(1, 0), b3, voffB); PG8_STAGE(PG8_SB(1, 1), b3 + hstep, voffB); PG8_STAGE(PG8_SA(1, 0), a3, voffA);
            PG8_WAIT_VX; PG8_XFOLD(2 * (8) + 3); PG8_WAIT_L(0); PG8_BAR; PG8_MMA(1, 0, At, B0); PG8_MMA(1, 1, At, B1); PG8_BAR; PG8_SCHED;
        }
        { constexpr int t = 10;
            const bool last = (t == nt - 2);
            const char* a1 = cA + (size_t)(t + 1) * kstep;
            const char* a2 = last ? nA : cA + (size_t)(t + 2) * kstep; const char* b2 = last ? nB : cB + (size_t)(t + 2) * kstep;
            const char* a3 = a2 + kstep; const char* b3 = b2 + kstep;
            if (last && has_next) S.a_ready(nxt);
            PG8_XISSUE(2 * (10) + 1); PG8_LDB(B0, 0, 0); PG8_LDB(B1, 0, 1); PG8_SCHED; PG8_LDA(At, 0, 0); PG8_STAGE(PG8_SA(1, 1), a1 + hstep, voffA);
            PG8_WAIT_VX; PG8_XFOLD(2 * (10)); PG8_WAIT_L(0); PG8_BAR; PG8_MMA(0, 0, At, B0); PG8_MMA(0, 1, At, B1); PG8_BAR; PG8_SCHED;
            PG8_XISSUE(2 * (10) + 2); PG8_LDA(At, 0, 1); PG8_STAGE(PG8_SB(0, 0), b2, voffB); PG8_STAGE(PG8_SB(0, 1), b2 + hstep, voffB); PG8_STAGE(PG8_SA(0, 0), a2, voffA);
            PG8_WAIT_VX; PG8_XFOLD(2 * (10) + 1); PG8_WAIT_L(0); PG8_BAR; PG8_MMA(1, 0, At, B0); PG8_MMA(1, 1, At, B1); PG8_BAR; PG8_SCHED;
            PG8_XISSUE(2 * (10) + 3); PG8_LDB(B0, 1, 0); PG8_LDB(B1, 1, 1); PG8_SCHED; PG8_LDA(At, 1, 0); PG8_STAGE(PG8_SA(0, 1), a2 + hstep, voffA);
            PG8_WAIT_VX; PG8_XFOLD(2 * (10) + 2); PG8_WAIT_L(0); PG8_BAR; PG8_MMA(0, 0, At, B0); PG8_MMA(0, 1, At, B1); PG8_BAR; PG8_SCHED;
            PG8_XISSUE(2 * (10) + 4); PG8_LDA(At, 1, 1); PG8_STAGE(PG8_SB(1, 0), b3, voffB); PG8_STAGE(PG8_SB(1, 1), b3 + hstep, voffB); PG8_STAGE(PG8_SA(1, 0), a3, voffA);
            PG8_WAIT_VX; PG8_XFOLD(2 * (10) + 3); PG8_WAIT_L(0); PG8_BAR; PG8_MMA(1, 0, At, B0); PG8_MMA(1, 1, At, B1); PG8_BAR; PG8_SCHED;
        }
        { constexpr int t = 12;
            const bool last = (t == nt - 2);
            const char* a1 = cA + (size_t)(t + 1) * kstep;
            const char* a2 = last ? nA : cA + (size_t)(t + 2) * kstep; const char* b2 = last ? nB : cB + (size_t)(t + 2) * kstep;
            const char* a3 = a2 + kstep; const char* b3 = b2 + kstep;
            if (last && has_next) S.a_ready(nxt);
            PG8_XISSUE(2 * (12) + 1); PG8_LDB(B0, 0, 0); PG8_LDB(B1, 0, 1); PG8_SCHED; PG8_LDA(At, 0, 0); PG8_STAGE(PG8_SA(1, 1), a1 + hstep, voffA);
            PG8_WAIT_VX; PG8_XFOLD(2 * (12)); PG8_WAIT_L(0); PG8_BAR; PG8_MMA(0, 0, At, B0); PG8_MMA(0, 1, At, B1); PG8_BAR; PG8_SCHED;
            PG8_XISSUE(2 * (12) + 2); PG8_LDA(At, 0, 1); PG8_STAGE(PG8_SB(0, 0), b2, voffB); PG8_STAGE(PG8_SB(0, 1), b2 + hstep, voffB); PG8_STAGE(PG8_SA(0, 0), a2, voffA);
            PG8_WAIT_VX; PG8_XFOLD(2 * (12) + 1); PG8_WAIT_L(0); PG8_BAR; PG8_MMA(1, 0, At, B0); PG8_MMA(1, 1, At, B1); PG8_BAR; PG8_SCHED;
            PG8_XISSUE(2 * (12) + 3); PG8_LDB(B0, 1, 0); PG8_LDB(B1, 1, 1); PG8_SCHED; PG8_LDA(At, 1, 0); PG8_STAGE(PG8_SA(0, 1), a2 + hstep, voffA);
            PG8_WAIT_VX; PG8_XFOLD(2 * (12) + 2); PG8_WAIT_L(0); PG8_BAR; PG8_MMA(0, 0, At, B0); PG8_MMA(0, 1, At, B1); PG8_BAR; PG8_SCHED;
            PG8_XISSUE(2 * (12) + 4); PG8_LDA(At, 1, 1); PG8_STAGE(PG8_SB(1, 0), b3, voffB); PG8_STAGE(PG8_SB(1, 1), b3 + hstep, voffB); PG8_STAGE(PG8_SA(1, 0), a3, voffA);
            PG8_WAIT_VX; PG8_XFOLD(2 * (12) + 3); PG8_WAIT_L(0); PG8_BAR; PG8_MMA(1, 0, At, B0); PG8_MMA(1, 1, At, B1); PG8_BAR; PG8_SCHED;
        }
        { constexpr int t = 14;
            const bool last = (t == nt - 2);
            const char* a1 = cA + (size_t)(t + 1) * kstep;
            const char* a2 = last ? nA : cA + (size_t)(t + 2) * kstep; const char* b2 = last ? nB : cB + (size_t)(t + 2) * kstep;
            const char* a3 = a2 + kstep; const char* b3 = b2 + kstep;
            if (last && has_next) S.a_ready(nxt);
            PG8_XISSUE(2 * (14) + 1); PG8_LDB(B0, 0, 0); PG8_LDB(B1, 0, 1); PG8_SCHED; PG8_LDA(At, 0, 0); PG8_STAGE(PG8_SA(1, 1), a1 + hstep, voffA);
            PG8_WAIT_VX; PG8_XFOLD(2 * (14)); PG8_WAIT_L(0); PG8_BAR; PG8_MMA(0, 0, At, B0); PG8_MMA(0, 1, At, B1); PG8_BAR; PG8_SCHED;
            PG8_XISSUE(2 * (14) + 2); PG8_LDA(At, 0, 1); PG8_STAGE(PG8_SB(0, 0), b2, voffB); PG8_STAGE(PG8_SB(0, 1), b2 + hstep, voffB); PG8_STAGE(PG8_SA(0, 0), a2, voffA);
            PG8_WAIT_VX; PG8_XFOLD(2 * (14) + 1); PG8_WAIT_L(0); PG8_BAR; PG8_MMA(1, 0, At, B0); PG8_MMA(1, 1, At, B1); PG8_BAR; PG8_SCHED;
            PG8_XISSUE(2 * (14) + 3); PG8_LDB(B0, 1, 0); PG8_LDB(B1, 1, 1); PG8_SCHED; PG8_LDA(At, 1, 0); PG8_STAGE(PG8_SA(0, 1), a2 + hstep, voffA);
            PG8_WAIT_VX; PG8_XFOLD(2 * (14) + 2); PG8_WAIT_L(0); PG8_BAR; PG8_MMA(0, 0, At, B0); PG8_MMA(0, 1, At, B1); PG8_BAR; PG8_SCHED;
            PG8_XISSUE(2 * (14) + 4); PG8_LDA(At, 1, 1); PG8_STAGE(PG8_SB(1, 0), b3, voffB); PG8_STAGE(PG8_SB(1, 1), b3 + hstep, voffB); PG8_STAGE(PG8_SA(1, 0), a3, voffA);
            PG8_WAIT_VX; PG8_XFOLD(2 * (14) + 3); PG8_WAIT_L(0); PG8_BAR; PG8_MMA(1, 0, At, B0); PG8_MMA(1, 1, At, B1); PG8_BAR; PG8_SCHED;
        }
        } else
        for (int t = 0; t < nt; t += 2) {
            const bool last = (t == nt - 2);
            const char* a1 = cA + (size_t)(t + 1) * kstep;
            const char* a2 = last ? nA : cA + (size_t)(t + 2) * kstep; const char* b2 = last ? nB : cB + (size_t)(t + 2) * kstep;
            const char* a3 = a2 + kstep; const char* b3 = b2 + kstep;
            if (last && has_next) S.a_ready(nxt);
            if constexpr (SP2) {
            PG8_LDB(B0, 0, 0); PG8_LDB(B1, 0, 1); PG8_SCHED; PG8_LDA(At, 0, 0); PG8_STAGE(PG8_SA(1, 1), a1 + hstep, voffA);
            PG8_WAIT_V(8); PG8_WAIT_L(0); PG8_BAR; PG8_MMA(0, 0, At, B0); PG8_MMA(0, 1, At, B1); PG8_BAR; PG8_SCHED;
            PG8_LDA(At, 0, 1); PG8_STAGE(PG8_SB(0, 0), b2, voffB); PG8_STAGE(PG8_SB(0, 1), b2 + hstep, voffB); PG8_STAGE(PG8_SA(0, 0), a2, voffA);
            PG8_WAIT_V(8); PG8_WAIT_L(0); PG8_BAR; PG8_MMA(1, 0, At, B0); PG8_MMA(1, 1, At, B1); PG8_BAR; PG8_SCHED;
            PG8_LDB(B0, 1, 0); PG8_LDB(B1, 1, 1); PG8_SCHED; PG8_LDA(At, 1, 0); PG8_STAGE(PG8_SA(0, 1), a2 + hstep, voffA);
            PG8_WAIT_V(8); PG8_WAIT_L(0); PG8_BAR; PG8_MMA(0, 0, At, B0); PG8_MMA(0, 1, At, B1); PG8_BAR; PG8_SCHED;
            PG8_LDA(At, 1, 1); PG8_STAGE(PG8_SB(1, 0), b3, voffB); PG8_STAGE(PG8_SB(1, 1), b3 + hstep, voffB); PG8_STAGE(PG8_SA(1, 0), a3, voffA);
            PG8_WAIT_V(8); PG8_WAIT_L(0); PG8_BAR; PG8_MMA(1, 0, At, B0); PG8_MMA(1, 1, At, B1); PG8_BAR; PG8_SCHED;
            } else {
            PG8_LDB(B0, 0, 0); PG8_SCHED; PG8_LDA(At, 0, 0); PG8_STAGE(PG8_SA(1, 1), a1 + hstep, voffA);
            PG8_WAIT_L(8); PG8_BAR; PG8_WAIT_L(0); PG8_MMA(0, 0, At, B0); PG8_BAR; PG8_SCHED;
            PG8_LDB(B1, 0, 1); PG8_STAGE(PG8_SB(0, 0), b2, voffB);
            PG8_BAR; PG8_WAIT_L(0); PG8_MMA(0, 1, At, B1); PG8_BAR;
            PG8_LDA(At, 0, 1); PG8_STAGE(PG8_SA(0, 0), a2, voffA);
            PG8_BAR; PG8_WAIT_L(0); PG8_MMA(1, 0, At, B0); PG8_BAR; PG8_SCHED;
            PG8_STAGE(PG8_SB(0, 1), b2 + hstep, voffB);
            PG8_WAIT_V(6); PG8_BAR; PG8_MMA(1, 1, At, B1); PG8_BAR;
            PG8_LDB(B0, 1, 0); PG8_SCHED; PG8_LDA(At, 1, 0); PG8_STAGE(PG8_SA(0, 1), a2 + hstep, voffA);
            PG8_WAIT_L(8); PG8_BAR; PG8_WAIT_L(0); PG8_MMA(0, 0, At, B0); PG8_BAR; PG8_SCHED;
            PG8_LDB(B1, 1, 1); PG8_STAGE(PG8_SB(1, 0), b3, voffB);
            PG8_BAR; PG8_WAIT_L(0); PG8_MMA(0, 1, At, B1); PG8_BAR;
            PG8_LDA(At, 1, 1); PG8_STAGE(PG8_SA(1, 0), a3, voffA);
            PG8_BAR; PG8_WAIT_L(0); PG8_MMA(1, 0, At, B0); PG8_BAR; PG8_SCHED;
            PG8_STAGE(PG8_SB(1, 1), b3 + hstep, voffB);
            PG8_WAIT_V(6); PG8_BAR; PG8_MMA(1, 1, At, B1); PG8_BAR;
            }
        }
        if constexpr (ALIGN_EPI) { if (wr == 0) PG8_BAR; }
        if constexpr (!Epi::AFTER_DRAIN) { E(acc, cur, wr, wc, fr, fq); S.done(cur); }
        if (!has_next) break;
#pragma unroll
        for (int a = 0; a < 2; ++a)
#pragma unroll
            for (int b = 0; b < 2; ++b)
#pragma unroll
                for (int m = 0; m < 4; ++m)
#pragma unroll
                    for (int n = 0; n < 2; ++n) acc[a][b][m][n] = (f32x4){0.f, 0.f, 0.f, 0.f};
        if constexpr (Epi::INIT) E.init(acc, nxt, wr, wc, fr, fq);
        cur = nxt; cA = nA; cB = nB; ++ui;
        if constexpr (ALIGN_EPI) { if (wr == 1) PG8_BAR; }
    }
    PG8_WAIT_V(0);
    if constexpr (!ALIGN_EPI) { if (wr == 0) PG8_BAR; }
    PG8_BAR;
    if constexpr (Epi::AFTER_DRAIN) { E.fused(acc, cur, wr, wc, fr, fq, lds, wid, lane); S.done(cur); }
#undef PG8_SA
#undef PG8_SB
#undef PG8_STAGE
#undef PG8_LDA
#undef PG8_LDB
#undef PG8_MMA
#undef PG8_WAIT_V
#undef PG8_WAIT_L
#undef PG8_WAIT_VX
#undef PG8_XISSUE
#undef PG8_XFOLD
#undef PG8_BAR
#undef PG8_SCHED
}
}

constexpr int BATCH = 8, SEQ = 4096, DMODEL = 1024, M = BATCH * SEQ;
constexpr int NIN = 3072;
constexpr int QLR = 256, KVLR = 128, DQK = 96;
constexpr float EPS = 1e-6f, LOG2E = 1.4426950408889634f;
constexpr float SCALE_A = 0.125f * LOG2E;
constexpr float SCALE_B = 0.10206207261596577f * LOG2E;
constexpr int NWAVES = 8;

constexpr size_t MiB = 1u << 20;
constexpr size_t WS_CTL = 0, CTL_ZERO_BYTES = 1 * MiB;
constexpr size_t WS_WIN = 2 * MiB, WS_WUQ = 8 * MiB, WS_WUKV = 9 * MiB, WS_WOUT = 10 * MiB;
constexpr size_t WS_CS = 12 * MiB;
constexpr size_t WS_BT = 16 * MiB;
constexpr size_t WS_GN = 16 * MiB + 65536;
constexpr int GN_AQ = 0, GN_AK = 64, GN_QN = 128, GN_QR = 192, GN_KN = 224, GN_KR = 288;
constexpr size_t WS_SSQ = 17 * MiB;
constexpr size_t WS_LP = 18 * MiB;
constexpr size_t WS_KR = 22 * MiB;
constexpr size_t WS_XN = 24 * MiB;
constexpr size_t WS_CQ = 88 * MiB;
constexpr size_t WS_CKV = 104 * MiB;
constexpr size_t WS_QA = 112 * MiB, WS_KA = 144 * MiB, WS_VA = 176 * MiB;
constexpr size_t WS_SZ = 208 * MiB;
constexpr size_t WS_QB = 272 * MiB;
constexpr size_t WS_KN = 320 * MiB, WS_VB = 352 * MiB;
constexpr size_t WS_MIX = 384 * MiB;
constexpr size_t WS_OP0 = 24 * MiB, WS_OP1 = 56 * MiB, WS_OP2 = 448 * MiB;
constexpr size_t WS_END = 480 * MiB;

constexpr int CW_TMO = 0, CW_BAR = 4096;

constexpr int RING_OFF = 0, RING_BYTES = 131072;
constexpr int LDSCTL_OFF = RING_BYTES, MISC_OFF = LDSCTL_OFF + 320;
constexpr int LDS_BYTES = 163840;

#define GAS __attribute__((address_space(1)))
#define LAS __attribute__((address_space(3)))
typedef unsigned short bf16;
typedef unsigned v4u __attribute__((ext_vector_type(4)));
typedef float f32x4 __attribute__((ext_vector_type(4)));
typedef float f32x16 __attribute__((ext_vector_type(16)));
typedef short bf16x8 __attribute__((ext_vector_type(8)));
typedef short s16x4 __attribute__((ext_vector_type(4)));
typedef GAS unsigned gu32;
#define RLX_AGENT __ATOMIC_RELAXED, __HIP_MEMORY_SCOPE_AGENT
#define LDS_WAIT() asm volatile("s_waitcnt lgkmcnt(0)" ::: "memory")
#define VM_WAIT() asm volatile("s_waitcnt vmcnt(0)" ::: "memory")
typedef float f32x2_t __attribute__((ext_vector_type(2))); typedef __bf16 bf16x2_t __attribute__((ext_vector_type(2)));
__device__ __forceinline__ unsigned pk2(float lo, float hi) { f32x2_t v = {lo, hi}; bf16x2_t b = __builtin_convertvector(v, bf16x2_t); return __builtin_bit_cast(unsigned, b); }
__device__ __forceinline__ float bf2f(unsigned short b) { return __uint_as_float((unsigned)b << 16); }
__device__ __forceinline__ float bflo(unsigned w) { return __uint_as_float(w << 16); }
__device__ __forceinline__ float bfhi(unsigned w) { return __uint_as_float(w & 0xffff0000u); }
__device__ __forceinline__ int crow(int r, int hi) { return (r & 3) + 8 * (r >> 2) + 4 * hi; }

#define XB_TMO      128
#define XB_XCNT(j)  (256  + 64 * (j))
#define XB_XSUB(j)  (1280 + 64 * (j))
#define XB_XGEN(j)  (2304 + 64 * (j))
#define XB_TOP      3328
#define XB_TOPGEN   3392
#define XCD_BAR_WORDS 3456
#define XB_SPIN_CAP (1u << 18)

__device__ __forceinline__ unsigned xb_ld(unsigned* p)              { return __hip_atomic_load(p, __ATOMIC_RELAXED, __HIP_MEMORY_SCOPE_AGENT); }
__device__ __forceinline__ unsigned xb_add(unsigned* p, unsigned v) { return __hip_atomic_fetch_add(p, v, __ATOMIC_RELAXED, __HIP_MEMORY_SCOPE_AGENT); }
__device__ __forceinline__ unsigned xb_xcc_id() { return (unsigned)__builtin_amdgcn_s_getreg((3 << 11) | 20) & 0xFu; }
#define XB_SPIN(cond, bar) do { unsigned _sp = 0; while (cond) { __builtin_amdgcn_s_sleep(1); \
    if ((++_sp & 255u) == 0u) { if (xb_ld(&(bar)[XB_TMO])) break; if (_sp > XB_SPIN_CAP) { atomicAdd(&(bar)[XB_TMO], 1u); break; } } } } while (0)

struct XcdBarrier {
    unsigned* bar; unsigned x;
    volatile LAS unsigned* st;
};

__device__ __forceinline__ XcdBarrier xcd_barrier_post(unsigned* bar, volatile LAS unsigned* st) {
    XcdBarrier b; b.bar = bar; b.x = xb_xcc_id(); b.st = st;
    if (threadIdx.x == 0) (void)xb_add(&bar[XB_XCNT(b.x)], 1u);
    return b;
}
__device__ __forceinline__ void xcd_barrier_complete(unsigned* bar, unsigned x, unsigned& nloc, unsigned& nx) {
    const unsigned G = gridDim.x * gridDim.y * gridDim.z;
    unsigned sum, cnt, mine, sp = 0u;
    for (;;) {
        sum = 0u; cnt = 0u; mine = 0u;
#pragma unroll
        for (unsigned j = 0; j < 16; ++j) { const unsigned c = xb_ld(&bar[XB_XCNT(j)]); sum += c; cnt += (c > 0u) ? 1u : 0u; mine = (j == x) ? c : mine; }
        if (sum == G) break;
        __builtin_amdgcn_s_sleep(1);
        if ((++sp & 255u) == 0u) { if (xb_ld(&bar[XB_TMO])) break; if (sp > XB_SPIN_CAP) { atomicAdd(&bar[XB_TMO], 1u); break; } }
    }
    nloc = mine > 0u ? mine : 1u; nx = cnt > 0u ? cnt : 1u;
}

__device__ __forceinline__ void xcd_barrier(const XcdBarrier& b) {
    asm volatile("s_waitcnt vmcnt(0)" ::: "memory");
    __syncthreads();
    if (threadIdx.x == 0) {
        unsigned* bar = b.bar;
        __builtin_amdgcn_s_waitcnt(0);
        unsigned nloc = b.st[0], nx = b.st[1];
        if (nloc == 0u) { xcd_barrier_complete(bar, b.x, nloc, nx); b.st[0] = nloc; b.st[1] = nx; }
        const unsigned old = xb_add(&bar[XB_XSUB(b.x)], 1u);
        const unsigned gen = old / nloc;
        if (old + 1u == (gen + 1u) * nloc) {
            __builtin_amdgcn_fence(__ATOMIC_RELEASE, "agent");
            asm volatile("s_waitcnt vmcnt(0)" ::: "memory");
            const unsigned og = xb_add(&bar[XB_TOP], 1u);
            const unsigned tg = og / nx;
            if (og + 1u == (tg + 1u) * nx) xb_add(&bar[XB_TOPGEN], 1u);
            else XB_SPIN(xb_ld(&bar[XB_TOPGEN]) == tg, bar);
            __builtin_amdgcn_fence(__ATOMIC_ACQUIRE, "agent");
            xb_add(&bar[XB_XGEN(b.x)], 1u);
            asm volatile("s_waitcnt vmcnt(0)" ::: "memory");
        } else {
            XB_SPIN(xb_ld(&bar[XB_XGEN(b.x)]) == gen, bar);
            __builtin_amdgcn_fence(__ATOMIC_ACQUIRE, "agent");
            asm volatile("s_waitcnt vmcnt(0)" ::: "memory");
        }
    }
    __syncthreads();
}


struct Frame {
    LAS unsigned char* lds;
    volatile LAS unsigned* MISC;
    gu32* ctl;
    int tid, lane, wave, vcu, G;
};
struct ProIn { const float *x, *rel_bias, *norm_gain, *w_in, *qc_gain, *w_uq, *kvc_gain, *w_ukv, *w_out; const int* positions; bf16 *WinT, *WuqT, *WukvT, *WoutT, *XN; float *CS, *BT; const float *aq, *ak, *qn, *qr, *kn, *kr; float* GN; };
struct MlaT { const bf16 *QB, *KN, *KR, *VB, *SZ; bf16* MIX; };

__device__ __forceinline__ float wave_sum(float v) {
#pragma unroll
    for (int o = 1; o < 64; o <<= 1) v += __shfl_xor(v, o);
    return v;
}
__device__ __forceinline__ void wprep_item(const float* W, int ldw, int src0, bf16* WT, int K, int dst_row0, const float* gk, LAS float* scr, int kb, int lane) {
    const int k0 = 64 * kb;
    if (src0 < 0) {
#pragma unroll
        for (int j = 0; j < 4; ++j) { const int n = (lane >> 3) + 8 * j; *(GAS v4u*)(WT + (size_t)(dst_row0 + n) * K + k0 + 8 * (lane & 7)) = (v4u){0u, 0u, 0u, 0u}; }
        return;
    }
#pragma unroll 8
    for (int i = 0; i < 32; ++i) { const int kk = 2 * i + (lane >> 5); const float g = gk ? gk[k0 + kk] : 1.0f; scr[kk * 33 + (lane & 31)] = W[(size_t)(k0 + kk) * ldw + src0 + (lane & 31)] * g; }
    LDS_WAIT(); asm volatile("" ::: "memory");
    const int c = lane & 7;
#pragma unroll
    for (int j = 0; j < 4; ++j) { const int n = (lane >> 3) + 8 * j; const LAS float* s = scr + (8 * c) * 33 + n;
        v4u o; o.x = pk2(s[0 * 33], s[1 * 33]); o.y = pk2(s[2 * 33], s[3 * 33]); o.z = pk2(s[4 * 33], s[5 * 33]); o.w = pk2(s[6 * 33], s[7 * 33]);
        *(GAS v4u*)(WT + (size_t)(dst_row0 + n) * K + k0 + 8 * c) = o; }
    LDS_WAIT(); asm volatile("" ::: "memory");
}
__device__ __forceinline__ int win_src(int db) {
    const int pn = db >> 3, p0 = (db & 7) * 32, bj = p0 >> 7, wc = (p0 & 127) >> 5;
    if (pn < 10) { const int seg = pn >> 1, T = pn & 1, head = 4 * T + wc; const int base = seg == 0 ? 0 : seg == 1 ? 512 : seg == 2 ? 1024 : seg == 3 ? 1536 : 2464; return base + head * 64 + 32 * bj; }
    if (pn == 10) return 2048 + 64 * wc + 32 * bj;
    if (wc < 2) return 2304 + 64 * wc + 32 * bj;
    if (wc == 2 && bj == 0) return 2432;
    return -1;
}
__device__ __forceinline__ int wuq_src(int db) { const int job = db >> 1, nh = db & 1; return job < 8 ? job * 96 + 32 * nh : (2 * (job - 8) + nh) * 96 + 64; }
__device__ __forceinline__ int wukv_src(int db) { const int job = db >> 1, nh = db & 1; return job < 8 ? job * 128 + 32 * nh : (job - 8) * 128 + 64 + 32 * nh; }
__device__ __forceinline__ int t5_bucket(int dist) {
    if (dist < 16) return dist;
    const float d = (float)dist;
    int large = 16 + (int)(logf(d / 16.0f) / 4.852030263919617f * 16.0f);
    return large < 31 ? large : 31;
}
__device__ __forceinline__ void sincos_rev(double f, float& s, float& c) {
    const double k = rint(4.0 * f); const double y = (f - 0.25 * k) * 6.283185307179586476925287;
    const double y2 = y * y;
    const double sy = y * (1.0 + y2 * (-1.0 / 6 + y2 * (1.0 / 120 + y2 * (-1.0 / 5040 + y2 * (1.0 / 362880 + y2 * (-1.0 / 39916800 + y2 * (1.0 / 6227020800.0)))))));
    const double cy = 1.0 + y2 * (-0.5 + y2 * (1.0 / 24 + y2 * (-1.0 / 720 + y2 * (1.0 / 40320 + y2 * (-1.0 / 3628800 + y2 * (1.0 / 479001600.0 + y2 * (-1.0 / 87178291200.0)))))));
    const int q = ((int)k) & 3;
    const double ss = (q == 0) ? sy : (q == 1) ? cy : (q == 2) ? -sy : -cy;
    const double cc = (q == 0) ? cy : (q == 1) ? -sy : (q == 2) ? -cy : sy;
    s = (float)ss; c = (float)cc;
}
__device__ __forceinline__ float inv_freq(int i) {
    const int e = i >> 2, r = i & 3;
    const double m = r == 0 ? 1.0 : r == 1 ? 0.5623413251903491 : r == 2 ? 0.31622776601683794 : 0.1778279410038923;
    const double p = e == 0 ? 1.0 : e == 1 ? 0.1 : e == 2 ? 0.01 : 0.001;
    return (float)(m * p);
}
__device__ __forceinline__ void p0_prologue(const Frame& F, const ProIn P) {
    LAS float* scr = (LAS float*)(F.lds + RING_OFF + F.wave * 16384);
    const int gw = F.vcu * NWAVES + F.wave, NGW = F.G * NWAVES;
    constexpr int I_IN = (NIN / 32) * (DMODEL / 64), I_UQ = (768 / 32) * (QLR / 64), I_UKV = (1024 / 32) * (KVLR / 64), I_OUT = (1024 / 32) * (1024 / 64);
    constexpr int NITEMS = I_IN + I_UQ + I_UKV + I_OUT;
    for (int it = gw; it < NITEMS; it += NGW) {
        int r = it;
        if (r < I_IN) { const int db = r / 16, kb = r % 16; wprep_item(P.w_in, 2976, win_src(db), P.WinT, DMODEL, 32 * db, nullptr, scr, kb, F.lane); continue; } r -= I_IN;
        if (r < I_UQ) { const int db = r / 4, kb = r % 4; wprep_item(P.w_uq, 768, wuq_src(db), P.WuqT, QLR, 32 * db, P.qc_gain, scr, kb, F.lane); continue; } r -= I_UQ;
        if (r < I_UKV) { const int db = r / 2, kb = r % 2; wprep_item(P.w_ukv, 1024, wukv_src(db), P.WukvT, KVLR, 32 * db, P.kvc_gain, scr, kb, F.lane); continue; } r -= I_UKV;
        { const int db = r / 16, kb = r % 16; wprep_item(P.w_out, 1024, 32 * db, P.WoutT, 1024, 32 * db, nullptr, scr, kb, F.lane); }
    }
    if (F.vcu == 0 && F.tid < 64) { const int t = F.tid; P.GN[GN_AQ + t] = P.aq[t]; P.GN[GN_AK + t] = P.ak[t]; P.GN[GN_QN + t] = P.qn[t]; P.GN[GN_KN + t] = P.kn[t]; if (t < 32) { P.GN[GN_QR + t] = P.qr[t]; P.GN[GN_KR + t] = P.kr[t]; } }
    { f32x4 g[4];
#pragma unroll
      for (int j = 0; j < 4; ++j) g[j] = *((const GAS f32x4*)P.norm_gain + F.lane + 64 * j);
      for (int m0 = 4 * gw; m0 < M; m0 += 4 * NGW) {
        f32x4 v[4][4]; float sq[4];
#pragma unroll
        for (int r = 0; r < 4; ++r) { const GAS f32x4* xr = (const GAS f32x4*)(P.x + (size_t)(m0 + r) * DMODEL) + F.lane;
#pragma unroll
            for (int j = 0; j < 4; ++j) v[r][j] = xr[64 * j]; }
#pragma unroll
        for (int r = 0; r < 4; ++r) { float s = 0.f;
#pragma unroll
            for (int j = 0; j < 4; ++j) s += (v[r][j].x * v[r][j].x + v[r][j].y * v[r][j].y) + (v[r][j].z * v[r][j].z + v[r][j].w * v[r][j].w);
            sq[r] = s; }
#pragma unroll
        for (int o = 1; o < 64; o <<= 1) {
#pragma unroll
            for (int r = 0; r < 4; ++r) sq[r] += __shfl_xor(sq[r], o); }
#pragma unroll
        for (int r = 0; r < 4; ++r) { const float rstd = rsqrtf(sq[r] * (1.f / DMODEL) + EPS);
            GAS unsigned long long* o8 = (GAS unsigned long long*)(P.XN + (size_t)(m0 + r) * DMODEL) + F.lane;
#pragma unroll
            for (int j = 0; j < 4; ++j) o8[64 * j] = (unsigned long long)pk2(v[r][j].x * rstd * g[j].x, v[r][j].y * rstd * g[j].y) | ((unsigned long long)pk2(v[r][j].z * rstd * g[j].z, v[r][j].w * rstd * g[j].w) << 32); }
      } }
    { const int gt = F.vcu * (NWAVES * 64) + F.tid, NGT = F.G * NWAVES * 64;
      for (int e = gt; e < M * 16; e += NGT) { const int row = e >> 4, i = e & 15;
          const float ang = (float)P.positions[row] * inv_freq(i);
          const double rev = (double)ang * 0.15915494309189533576888; const double f = rev - rint(rev);
          float s, c; sincos_rev(f, s, c); P.CS[(size_t)row * 32 + i] = c; P.CS[(size_t)row * 32 + 16 + i] = s; }
      for (int e = gt; e < 3 * 8 * 192; e += NGT) { const int p = e / (8 * 192), h = (e / 192) % 8, ix = e % 192; const int delta = ix - 31; const int dil = p == 0 ? 1 : p == 1 ? 4 : 16;
          float v = -INFINITY; if (delta >= 0 && delta <= 128) v = LOG2E * P.rel_bias[t5_bucket(delta * dil) * 8 + h];
          P.BT[e] = v; }
    }
}

typedef pg8::Unit Unit;
__device__ __forceinline__ float dot4(const f32x4 a) { return (a[0] * a[0] + a[1] * a[1]) + (a[2] * a[2] + a[3] * a[3]); }
__device__ __forceinline__ float qsum(float s) { s += __shfl_xor(s, 16); s += __shfl_xor(s, 32); return s; }
__device__ __forceinline__ v4u pack8(const f32x4 a, const f32x4 b) { v4u w; w.x = pk2(a[0], a[1]); w.y = pk2(a[2], a[3]); w.z = pk2(b[0], b[1]); w.w = pk2(b[2], b[3]); return w; }
__device__ __forceinline__ float silu1(float z) { return z * __builtin_amdgcn_rcpf(1.0f + __builtin_amdgcn_exp2f(-z * LOG2E)); }
__device__ __forceinline__ f32x4 silu4(const f32x4 z) { return (f32x4){silu1(z[0]), silu1(z[1]), silu1(z[2]), silu1(z[3])}; }
__device__ __forceinline__ void rope8(f32x4& t0, f32x4& t1, const float* cs, int fq) {
    f32x4 p0, p1;
#pragma unroll
    for (int e = 0; e < 4; ++e) { p0[e] = __shfl_xor(t0[e], 32); p1[e] = __shfl_xor(t1[e], 32); }
    const f32x4 c0 = *(const f32x4*)(cs + 8 * (fq & 1)), c1 = *(const f32x4*)(cs + 8 * (fq & 1) + 4), s0 = *(const f32x4*)(cs + 16 + 8 * (fq & 1)), s1 = *(const f32x4*)(cs + 16 + 8 * (fq & 1) + 4);
    const float sg = fq < 2 ? -1.0f : 1.0f;
    t0 = t0 * c0 + sg * (p0 * s0); t1 = t1 * c1 + sg * (p1 * s1);
}

__device__ __forceinline__ unsigned swap_adj(unsigned v) { return (unsigned)__builtin_amdgcn_update_dpp(0, (int)v, 0xB1, 0xF, 0xF, false); }
__device__ __forceinline__ void store_rows2(bf16* p, int stride, const v4u A, const v4u B, int e) {
    v4u d1, d2;
#pragma unroll
    for (int k = 0; k < 4; ++k) { const unsigned snd = e ? A[k] : B[k], rcv = swap_adj(snd); d1[k] = e ? rcv : A[k]; d2[k] = e ? B[k] : rcv; }
    bf16* p1 = p + (e ? 32 - stride : 0);
    *(v4u*)p1 = d1; *(v4u*)(p1 + stride) = d2;
}
struct EpiP1 {
    static constexpr bool PERM = true, AFTER_DRAIN = false, INIT = false, XFOLD = false;
    unsigned char* ws;
    __device__ __forceinline__ void operator()(const f32x4 (&acc)[2][2][4][2], const Unit& u, int wr, int wc, int fr_, int fq_) const {
        int fr = fr_, fq = fq_; asm volatile("" : "+v"(fr), "+v"(fq));
        bf16 *QA = (bf16*)(ws + WS_QA), *KA = (bf16*)(ws + WS_KA), *VA = (bf16*)(ws + WS_VA), *SZ = (bf16*)(ws + WS_SZ), *CQ = (bf16*)(ws + WS_CQ), *CKV = (bf16*)(ws + WS_CKV), *KR = (bf16*)(ws + WS_KR);
        float* SSQ = (float*)(ws + WS_SSQ); const float *GN = (const float*)(ws + WS_GN), *aq = GN + GN_AQ, *ak = GN + GN_AK, *krg = GN + GN_KR, *CS = (const float*)(ws + WS_CS);
        const int pn = u.pn; const int row0 = u.pm * 256 + wr * 64 + fr;
        if (pn < 4) {
            const float* g = pn < 2 ? aq : ak; const float sc = pn < 2 ? SCALE_A : 1.0f; bf16* dst = (pn < 2 ? QA : KA) + (4 * (pn & 1) + wc) * 64 + 8 * fq;
            const f32x4 g00 = *(const f32x4*)(g + 8 * fq), g01 = *(const f32x4*)(g + 8 * fq + 4), g10 = *(const f32x4*)(g + 32 + 8 * fq), g11 = *(const f32x4*)(g + 32 + 8 * fq + 4);
#pragma unroll
            for (int ai = 0; ai < 2; ++ai)
#pragma unroll
                for (int m = 0; m < 4; ++m) { const f32x4 a0 = acc[ai][0][m][0], a1 = acc[ai][0][m][1], b0 = acc[ai][1][m][0], b1 = acc[ai][1][m][1];
                    const float ss = qsum((dot4(a0) + dot4(a1)) + (dot4(b0) + dot4(b1))); const float rs = rsqrtf(ss * (1.0f / 64.0f) + EPS) * sc;
                    bf16* p = dst + (size_t)(row0 + ai * 128 + m * 16) * 512;
                    store_rows2(p, 512, pack8(a0 * g00 * rs, a1 * g01 * rs), pack8(b0 * g10 * rs, b1 * g11 * rs), fr & 1); }
        } else if (pn < 6) {
            bf16* dst = VA + (4 * (pn & 1) + wc) * 64 + 8 * fq;
#pragma unroll
            for (int ai = 0; ai < 2; ++ai)
#pragma unroll
                for (int m = 0; m < 4; ++m) { bf16* p = dst + (size_t)(row0 + ai * 128 + m * 16) * 512;
                    store_rows2(p, 512, pack8(acc[ai][0][m][0], acc[ai][0][m][1]), pack8(acc[ai][1][m][0], acc[ai][1][m][1]), fr & 1); }
        } else if (pn < 10) {
            bf16* dst = SZ + (pn - 6) * 256 + wc * 64 + 8 * fq;
#pragma unroll
            for (int ai = 0; ai < 2; ++ai)
#pragma unroll
                for (int m = 0; m < 4; ++m) { bf16* p = dst + (size_t)(row0 + ai * 128 + m * 16) * 1024;
                    store_rows2(p, 1024, pack8(silu4(acc[ai][0][m][0]), silu4(acc[ai][0][m][1])), pack8(silu4(acc[ai][1][m][0]), silu4(acc[ai][1][m][1])), fr & 1); }
        } else if (pn == 10) {
            bf16* dst = CQ + wc * 64 + 8 * fq;
#pragma unroll
            for (int ai = 0; ai < 2; ++ai)
#pragma unroll
                for (int m = 0; m < 4; ++m) { const f32x4 a0 = acc[ai][0][m][0], a1 = acc[ai][0][m][1], b0 = acc[ai][1][m][0], b1 = acc[ai][1][m][1]; const int row = row0 + ai * 128 + m * 16;
                    const float ss = qsum((dot4(a0) + dot4(a1)) + (dot4(b0) + dot4(b1))); if (fq == 0) SSQ[(size_t)row * 8 + wc] = ss;
                    bf16* p = dst + (size_t)row * 256; store_rows2(p, 256, pack8(a0, a1), pack8(b0, b1), fr & 1); }
        } else {
            if (wc < 2) {
                bf16* dst = CKV + wc * 64 + 8 * fq;
#pragma unroll
                for (int ai = 0; ai < 2; ++ai)
#pragma unroll
                    for (int m = 0; m < 4; ++m) { const f32x4 a0 = acc[ai][0][m][0], a1 = acc[ai][0][m][1], b0 = acc[ai][1][m][0], b1 = acc[ai][1][m][1]; const int row = row0 + ai * 128 + m * 16;
                        const float ss = qsum((dot4(a0) + dot4(a1)) + (dot4(b0) + dot4(b1))); if (fq == 0) SSQ[(size_t)row * 8 + 4 + wc] = ss;
                        bf16* p = dst + (size_t)row * 128; store_rows2(p, 128, pack8(a0, a1), pack8(b0, b1), fr & 1); }
            } else if (wc == 2) {
                const f32x4 g0 = *(const f32x4*)(krg + 8 * fq), g1 = *(const f32x4*)(krg + 8 * fq + 4);
#pragma unroll
                for (int ai = 0; ai < 2; ++ai)
#pragma unroll
                    for (int m = 0; m < 4; ++m) { const f32x4 a0 = acc[ai][0][m][0], a1 = acc[ai][0][m][1]; const int row = row0 + ai * 128 + m * 16;
                        const float ss = qsum(dot4(a0) + dot4(a1)); const float rs = rsqrtf(ss * (1.0f / 32.0f) + EPS);
                        f32x4 t0 = a0 * g0 * rs, t1 = a1 * g1 * rs; rope8(t0, t1, CS + (size_t)row * 32, fq);
                        *(v4u*)(KR + (size_t)row * 32 + 8 * fq) = pack8(t0, t1); }
            }
        }
    }
};
struct EpiP2q {
    static constexpr bool PERM = true, AFTER_DRAIN = false, INIT = false, XFOLD = false;
    unsigned char* ws;
    __device__ __forceinline__ void operator()(const f32x4 (&acc)[2][2][4][2], const Unit& u, int wr, int wc, int fr_, int fq_) const {
        int fr = fr_, fq = fq_; asm volatile("" : "+v"(fr), "+v"(fq));
        bf16* QB = (bf16*)(ws + WS_QB); const float *SSQ = (const float*)(ws + WS_SSQ), *GN = (const float*)(ws + WS_GN), *qn = GN + GN_QN, *qr = GN + GN_QR, *CS = (const float*)(ws + WS_CS);
        const int pn = u.pn; const int row0 = u.pm * 256 + wr * 64 + fr;
        if (pn < 2) {
            bf16* dst = QB + (4 * pn + wc) * 96 + 8 * fq;
            const f32x4 g00 = *(const f32x4*)(qn + 8 * fq), g01 = *(const f32x4*)(qn + 8 * fq + 4), g10 = *(const f32x4*)(qn + 32 + 8 * fq), g11 = *(const f32x4*)(qn + 32 + 8 * fq + 4);
#pragma unroll
            for (int ai = 0; ai < 2; ++ai)
#pragma unroll
                for (int m = 0; m < 4; ++m) { const int row = row0 + ai * 128 + m * 16; const f32x4 sq = *(const f32x4*)(SSQ + (size_t)row * 8);
                    const float rc = rsqrtf(((sq[0] + sq[1]) + (sq[2] + sq[3])) * (1.0f / 256.0f) + EPS);
                    const f32x4 a0 = acc[ai][0][m][0] * rc, a1 = acc[ai][0][m][1] * rc, b0 = acc[ai][1][m][0] * rc, b1 = acc[ai][1][m][1] * rc;
                    const float ss = qsum((dot4(a0) + dot4(a1)) + (dot4(b0) + dot4(b1))); const float rs = rsqrtf(ss * (1.0f / 64.0f) + EPS) * SCALE_B;
                    bf16* p = dst + (size_t)row * 768; *(v4u*)p = pack8(a0 * g00 * rs, a1 * g01 * rs); *(v4u*)(p + 32) = pack8(b0 * g10 * rs, b1 * g11 * rs); asm volatile("" ::: "memory"); }
        } else {
            const f32x4 g0 = *(const f32x4*)(qr + 8 * fq), g1 = *(const f32x4*)(qr + 8 * fq + 4);
#pragma unroll
            for (int ai = 0; ai < 2; ++ai)
#pragma unroll
                for (int m = 0; m < 4; ++m) { const int row = row0 + ai * 128 + m * 16; const f32x4 sq = *(const f32x4*)(SSQ + (size_t)row * 8);
                    const float rc = rsqrtf(((sq[0] + sq[1]) + (sq[2] + sq[3])) * (1.0f / 256.0f) + EPS);
#pragma unroll
                    for (int bj = 0; bj < 2; ++bj) { const f32x4 a0 = acc[ai][bj][m][0] * rc, a1 = acc[ai][bj][m][1] * rc;
                        const float ss = qsum(dot4(a0) + dot4(a1)); const float rs = rsqrtf(ss * (1.0f / 32.0f) + EPS);
                        f32x4 t0 = a0 * g0 * rs, t1 = a1 * g1 * rs; rope8(t0, t1, CS + (size_t)row * 32, fq);
                        *(v4u*)(QB + (size_t)row * 768 + (2 * wc + bj) * 96 + 64 + 8 * fq) = pack8(t0 * SCALE_B, t1 * SCALE_B); asm volatile("" ::: "memory"); } }
        }
    }
};
struct EpiP2kv {
    static constexpr bool PERM = true, AFTER_DRAIN = false, INIT = false, XFOLD = false;
    unsigned char* ws;
    __device__ __forceinline__ void operator()(const f32x4 (&acc)[2][2][4][2], const Unit& u, int wr, int wc, int fr_, int fq_) const {
        int fr = fr_, fq = fq_; asm volatile("" : "+v"(fr), "+v"(fq));
        bf16 *KN = (bf16*)(ws + WS_KN), *VB = (bf16*)(ws + WS_VB); const float *SSQ = (const float*)(ws + WS_SSQ), *kn = (const float*)(ws + WS_GN) + GN_KN;
        const int pn = u.pn; const int row0 = u.pm * 256 + wr * 64 + fr;
        bf16* dst = (pn < 2 ? KN : VB) + (4 * (pn & 1) + wc) * 64 + 8 * fq;
        f32x4 g00 = (f32x4){1.f, 1.f, 1.f, 1.f}, g01 = g00, g10 = g00, g11 = g00;
        if (pn < 2) { g00 = *(const f32x4*)(kn + 8 * fq); g01 = *(const f32x4*)(kn + 8 * fq + 4); g10 = *(const f32x4*)(kn + 32 + 8 * fq); g11 = *(const f32x4*)(kn + 32 + 8 * fq + 4); }
#pragma unroll
        for (int ai = 0; ai < 2; ++ai)
#pragma unroll
            for (int m = 0; m < 4; ++m) { const int row = row0 + ai * 128 + m * 16;
                const float rc = rsqrtf((SSQ[(size_t)row * 8 + 4] + SSQ[(size_t)row * 8 + 5]) * (1.0f / 128.0f) + EPS);
                const f32x4 a0 = acc[ai][0][m][0] * rc, a1 = acc[ai][0][m][1] * rc, b0 = acc[ai][1][m][0] * rc, b1 = acc[ai][1][m][1] * rc;
                float rs = 1.0f;
                if (pn < 2) { const float ss = qsum((dot4(a0) + dot4(a1)) + (dot4(b0) + dot4(b1))); rs = rsqrtf(ss * (1.0f / 64.0f) + EPS); }
                bf16* p = dst + (size_t)row * 512; *(v4u*)p = pack8(a0 * g00 * rs, a1 * g01 * rs); *(v4u*)(p + 32) = pack8(b0 * g10 * rs, b1 * g11 * rs); asm volatile("" ::: "memory"); }
    }
};
__device__ __forceinline__ void store_rows2f(float* p, const f32x4 A, const f32x4 B, int e) {
    f32x4 d1, d2;
#pragma unroll
    for (int k = 0; k < 4; ++k) { const float snd = e ? A[k] : B[k], rcv = __uint_as_float(swap_adj(__float_as_uint(snd))); d1[k] = e ? rcv : A[k]; d2[k] = e ? B[k] : rcv; }
    float* p1 = p + (e ? 16 - 1024 : 0);
    __builtin_nontemporal_store(d1, (f32x4*)p1); __builtin_nontemporal_store(d2, (f32x4*)(p1 + 1024));
}
__device__ __forceinline__ void load_rows2f(const float* p, f32x4& A, f32x4& B, int e) {
    const float* p1 = p + (e ? 16 - 1024 : 0);
    const f32x4 d1 = __builtin_nontemporal_load((const f32x4*)p1), d2 = __builtin_nontemporal_load((const f32x4*)(p1 + 1024));
#pragma unroll
    for (int k = 0; k < 4; ++k) { const float snd = e ? d1[k] : d2[k], rcv = __uint_as_float(swap_adj(__float_as_uint(snd))); A[k] = e ? rcv : d1[k]; B[k] = e ? d2[k] : rcv; }
}
struct EpiOut {
    static constexpr bool PERM = false, AFTER_DRAIN = false, INIT = false, XFOLD = true;
    const float* x; float* out;
    __device__ __forceinline__ const char* xtile(const Unit& u, int wr, int wc) const { return (const char*)(x + (size_t)(u.pm * 256 + wr * 64) * 1024 + u.pn * 256 + wc * 32); }
    __device__ __forceinline__ size_t xchunk_off(int k, int lane) const { const int ai = k >> 4, m = (k >> 2) & 3, bj = (k >> 1) & 1, n = k & 1, row = lane >> 2, pc = (lane & 3) ^ (row & 3);
        return ((size_t)(ai * 128 + m * 16 + row) * 1024 + bj * 128 + n * 16) * 4 + pc * 16; }
    __device__ __forceinline__ int xread_off(int fr, int fq) const { return fr * 64 + ((fq ^ (fr & 3)) * 16); }
    __device__ __forceinline__ void operator()(const f32x4 (&acc)[2][2][4][2], const Unit& u, int wr, int wc, int fr_, int fq_) const {
        int fr = fr_, fq = fq_; asm volatile("" : "+v"(fr), "+v"(fq));
        const int row0 = u.pm * 256 + wr * 64 + fr, col0 = u.pn * 256 + wc * 32 + 4 * fq;
#pragma unroll
        for (int ai = 0; ai < 2; ++ai)
#pragma unroll
            for (int m = 0; m < 4; ++m) { const size_t off = (size_t)(row0 + ai * 128 + m * 16) * 1024 + col0;
#pragma unroll
                for (int bj = 0; bj < 2; ++bj) store_rows2f(out + off + bj * 128, acc[ai][bj][m][0], acc[ai][bj][m][1], fr & 1); }
    }
};

typedef LAS const char* lds_cptr;
typedef short v4i16_t __attribute__((ext_vector_type(4)));
__device__ __forceinline__ s16x4 vtr(lds_cptr p) { return __builtin_bit_cast(s16x4, __builtin_amdgcn_ds_read_tr16_b64_v4i16((LAS v4i16_t*)p)); }
#define MFMA32(a, b, c) __builtin_amdgcn_mfma_f32_32x32x16_bf16(a, b, c, 0, 0, 0)
__device__ __forceinline__ float half_swap_add(float v) { auto rr = __builtin_amdgcn_permlane32_swap(__float_as_uint(v), __float_as_uint(v), false, false); return __uint_as_float(rr[0]) + __uint_as_float(rr[1]); }

namespace mla2 {
constexpr int KSLOT = 12288, VSLOT = 8192, NSLOT = 3;
constexpr int LDS_K = 0, LDS_V = NSLOT * KSLOT, LDS_WS = LDS_V + NSLOT * VSLOT, LDS_OST = LDS_WS + NWAVES * 256, LDS_SZ = LDS_OST + NWAVES * 4096, LDS_TOTAL = LDS_SZ + NWAVES * 4096;
#define SBAR() __builtin_amdgcn_sched_barrier(0)
#define PIN(x) asm volatile("" : "+v"(x))
#define WAIT_BAR(N) asm volatile("s_waitcnt vmcnt(" #N ") lgkmcnt(0)\n\ts_barrier" ::: "memory")
__device__ __forceinline__ void glds16s(const void* sbase, unsigned voff, unsigned lds_base) {
    unsigned sv; asm volatile("s_mov_b32 %0, m0\n\ts_mov_b32 m0, %3\n\ts_nop 0\n\tglobal_load_lds_dwordx4 %1, %2\n\ts_mov_b32 m0, %0" : "=&s"(sv) : "v"(voff), "s"(sbase), "s"(lds_base) : "memory"); }
__device__ __forceinline__ void kload2(bf16x8* kf, lds_cptr kp, int d0) { kf[2 * d0] = *(const LAS bf16x8*)(kp + d0 * 2048); kf[2 * d0 + 1] = *(const LAS bf16x8*)(kp + d0 * 2048 + 512); }
__device__ __forceinline__ void cmask(f32x16& p0, f32x16& p1, int jb, int qrel, int hi) {
    const int kb = 64 * jb + 4 * hi;
#pragma unroll
    for (int r = 0; r < 16; ++r) { const int kv = kb + (r & 3) + 8 * (r >> 2); if (kv > qrel) p0[r] = -INFINITY; if (kv + 32 > qrel) p1[r] = -INFINITY; } }

__device__ __forceinline__ void unit(int b, int h, int qb, const MlaT T, char* lds) {
    const int tid = threadIdx.x, lane = tid & 63, r32 = lane & 31, hi = lane >> 5; const int wid = __builtin_amdgcn_readfirstlane(tid >> 6);
    const long rowbase = (long)b * SEQ; const int q0 = qb * 256, NT = (q0 + 256) / 64;
    const bf16* Qw = T.QB + (rowbase + q0 + wid * 32) * 768 + h * 96;
    const unsigned lds0 = (unsigned)(uintptr_t)lds;
    const bf16* const kbn = T.KN + rowbase * 512 + h * 64; const bf16* const kbr = T.KR + rowbase * 32; const bf16* const vbs = T.VB + rowbase * 512 + h * 64;
    const unsigned kon = (unsigned)lane * 1024u + (unsigned)wid * 16u, kor = (unsigned)lane * 64u + (unsigned)(wid & 3) * 16u;
    const unsigned vof = (unsigned)(16 * (wid & 3) + (lane >> 2)) * 1024u + (unsigned)(wid >> 2) * 64u + (unsigned)(lane & 3) * 16u;
    const unsigned kdn = lds0 + LDS_K + wid * 1024, kdr = lds0 + LDS_K + (8 + (wid & 3)) * 1024, vdst = lds0 + LDS_V + wid * 1024;
#define DMA_K(t, slot) do { glds16s(kbn + (long)(t) * 64 * 512, kon, (unsigned)__builtin_amdgcn_readfirstlane(kdn + (slot))); glds16s(kbr + (long)(t) * 64 * 32, kor, (unsigned)__builtin_amdgcn_readfirstlane(kdr + (slot))); } while (0)
#define DMA_V(t, slot) glds16s(vbs + (long)(t) * 64 * 512, vof, (unsigned)__builtin_amdgcn_readfirstlane(vdst + (slot)))
    const lds_cptr vp0 = (lds_cptr)lds + LDS_V + ((lane >> 4) & 1) * 32 + (lane & 3) * 8 + (4 * hi + ((lane & 15) >> 2)) * 64;
    const lds_cptr kp0 = (lds_cptr)lds + LDS_K + hi * 1024 + r32 * 16;
    DMA_K(0, 0); DMA_V(0, 0); DMA_K(1, KSLOT);
    bf16x8 qr[6];
#pragma unroll
    for (int d0 = 0; d0 < 6; ++d0) qr[d0] = *reinterpret_cast<const bf16x8*>(&Qw[(long)r32 * 768 + d0 * 16 + hi * 8]);
    float l_reg = 0.f; f32x16 o[2]; o[0] = f32x16{}; o[1] = f32x16{};
    const f32x16 zero16 = f32x16{};
    const int qrel = wid * 32 + r32;
    f32x16 pA0, pA1, pB0, pB1; bf16x8 kf[12]; s16x4 vlo[8], vhi[8]; v4u pw0, pw1, pw2, pw3;
    int ks_cur = 0, ks_next = KSLOT, vs_prev = 0, vs_cur = 0, vs_next = VSLOT;
#define ROT() do { ks_cur = ks_next; ks_next = (ks_next == 2 * KSLOT) ? 0 : ks_next + KSLOT; vs_prev = vs_cur; vs_cur = vs_next; vs_next = (vs_next == 2 * VSLOT) ? 0 : vs_next + VSLOT; } while (0)
#define EX(v) __builtin_amdgcn_exp2f(v)
    DMA_K(2, 2 * KSLOT);
    WAIT_BAR(5);
#pragma unroll
    for (int d0 = 0; d0 < 6; ++d0) kload2(kf, kp0, d0);
    pA0 = MFMA32(kf[0], qr[0], zero16); pA1 = MFMA32(kf[1], qr[0], zero16);
#pragma unroll
    for (int d0 = 1; d0 < 6; ++d0) { pA0 = MFMA32(kf[2 * d0], qr[d0], pA0); pA1 = MFMA32(kf[2 * d0 + 1], qr[d0], pA1); }
    if (NT == 4) cmask(pA0, pA1, 0, qrel, hi);
#pragma unroll
    for (int r = 0; r < 16; ++r) { pA0[r] = EX(pA0[r]); pA1[r] = EX(pA1[r]); }
    WAIT_BAR(0);
    DMA_K(3, 0); DMA_V(1, VSLOT); ROT();
#pragma unroll
    for (int d0 = 0; d0 < 6; ++d0) kload2(kf, kp0 + ks_cur, d0);
    WAIT_BAR(3);
    { const bf16* zb = T.SZ + (rowbase + q0 + wid * 32) * 1024 + 512 + h * 64; const unsigned zo = (unsigned)(lane >> 3) * 2048u + (unsigned)(lane & 7) * 16u;
#pragma unroll
      for (int i = 0; i < 4; ++i) glds16s(zb + (long)(8 * i) * 1024, zo, (unsigned)__builtin_amdgcn_readfirstlane(lds0 + LDS_SZ + wid * 4096 + i * 1024)); }
#define PKW(P, i) pk2(P[i], P[i + 1])
#define PAF(k) __builtin_bit_cast(bf16x8, pw##k)
#define VFR(i) (bf16x8){vlo[i][0], vlo[i][1], vlo[i][2], vlo[i][3], vhi[i][0], vhi[i][1], vhi[i][2], vhi[i][3]}
#define VRD(i) do { vlo[i] = vtr(vp_ + (((i) >> 2) * 4096 + ((i) & 3) * 1024)); vhi[i] = vtr(vp_ + (((i) >> 2) * 4096 + ((i) & 3) * 1024 + 512)); } while (0)
#define KRD(G, d0) do { if (G) { kload2(kf, kp0 + ks_next, d0); SBAR(); } } while (0)
#define GA3(MF, a0, a1, a2, WW, PW) do { MF; sacc += a0; sacc += a1; sacc += a2; WW; PIN(PW); PIN(sacc); SBAR(); } while (0)
#define GAPB(MF, X, i) do { MF; X[i] = EX(X[i]); X[i + 1] = EX(X[i + 1]); X[i + 2] = EX(X[i + 2]); X[i + 3] = EX(X[i + 3]); PIN(X); SBAR(); } while (0)
#define STEP(C0, C1, P0, P1, t, MASK, GK, GV, GL) do { SBAR(); \
    const lds_cptr vp_ = vp0 + vs_prev; \
    VRD(0); SBAR(); float sacc = P0[0] + P0[1]; \
                    GA3(C0 = MFMA32(kf[0], qr[0], zero16), P0[2], P0[3], P0[4],   pw0[0] = PKW(P0, 0); pw0[1] = PKW(P0, 2),   pw0); \
    VRD(4); SBAR(); GA3(C1 = MFMA32(kf[1], qr[0], zero16), P0[5], P0[6], P0[7],   pw0[2] = PKW(P0, 4); pw0[3] = PKW(P0, 6),   pw0); \
    VRD(1); SBAR(); GA3(C0 = MFMA32(kf[2], qr[1], C0),     P0[8], P0[9], P0[10],  pw1[0] = PKW(P0, 8); pw1[1] = PKW(P0, 10),  pw1); \
    VRD(5); SBAR(); GA3(C1 = MFMA32(kf[3], qr[1], C1),     P0[11], P0[12], P0[13], pw1[2] = PKW(P0, 12); pw1[3] = PKW(P0, 14), pw1); \
    VRD(2); SBAR(); GA3(C0 = MFMA32(kf[4], qr[2], C0),     P0[14], P0[15], P1[0], pw2[0] = PKW(P1, 0),  pw2); \
    VRD(6); SBAR(); GA3(C1 = MFMA32(kf[5], qr[2], C1),     P1[1], P1[2], P1[3],   pw2[1] = PKW(P1, 2),  pw2); \
    VRD(3); SBAR(); GA3(C0 = MFMA32(kf[6], qr[3], C0),     P1[4], P1[5], P1[6],   pw2[2] = PKW(P1, 4),  pw2); \
    VRD(7); SBAR(); GA3(C1 = MFMA32(kf[7], qr[3], C1),     P1[7], P1[8], P1[9],   pw2[3] = PKW(P1, 6),  pw2); \
                    GA3(C0 = MFMA32(kf[8], qr[4], C0),     P1[10], P1[11], P1[12], pw3[0] = PKW(P1, 8),  pw3); \
                    GA3(C1 = MFMA32(kf[9], qr[4], C1),     P1[13], P1[14], P1[15], pw3[1] = PKW(P1, 10), pw3); \
                    GA3(C0 = MFMA32(kf[10], qr[5], C0),    0.f, 0.f, 0.f,          pw3[2] = PKW(P1, 12), pw3); \
                    GA3(C1 = MFMA32(kf[11], qr[5], C1),    0.f, 0.f, 0.f,          pw3[3] = PKW(P1, 14), pw3); \
    l_reg += sacc; \
    if (GK) DMA_K((t) + 3, ks_cur); if (GV) DMA_V((t) + 1, vs_next); \
    if (MASK) cmask(C0, C1, (t) - (NT - 4), qrel, hi); \
    SBAR(); \
    GAPB(o[0] = MFMA32(PAF(0), VFR(0), o[0]), C0, 0);              KRD(GL, 0); GAPB(o[1] = MFMA32(PAF(0), VFR(4), o[1]), C0, 4); \
    KRD(GL, 1); GAPB(o[0] = MFMA32(PAF(1), VFR(1), o[0]), C0, 8);  KRD(GL, 2); GAPB(o[1] = MFMA32(PAF(1), VFR(5), o[1]), C0, 12); \
    KRD(GL, 3); GAPB(o[0] = MFMA32(PAF(2), VFR(2), o[0]), C1, 0);  KRD(GL, 4); GAPB(o[1] = MFMA32(PAF(2), VFR(6), o[1]), C1, 4); \
    KRD(GL, 5); GAPB(o[0] = MFMA32(PAF(3), VFR(3), o[0]), C1, 8);              GAPB(o[1] = MFMA32(PAF(3), VFR(7), o[1]), C1, 12); \
    } while (0)
    int t = 1;
    for (; t + 5 < NT; t += 2) {
        STEP(pB0, pB1, pA0, pA1, t, false, true, true, true);     WAIT_BAR(3); ROT();
        STEP(pA0, pA1, pB0, pB1, t + 1, false, true, true, true); WAIT_BAR(3); ROT();
    }
#define ENDW(tt) do { if ((tt) + 3 < NT) { WAIT_BAR(3); } else if ((tt) + 2 < NT) { WAIT_BAR(1); } else { WAIT_BAR(0); } } while (0)
    for (; t + 1 < NT; t += 2) {
        STEP(pB0, pB1, pA0, pA1, t, (t >= NT - 4), (t + 3 < NT), (t + 1 < NT), (t + 1 < NT));         ENDW(t);     ROT();
        STEP(pA0, pA1, pB0, pB1, t + 1, (t + 1 >= NT - 4), (t + 4 < NT), (t + 2 < NT), (t + 2 < NT)); ENDW(t + 1); ROT();
    }
    STEP(pB0, pB1, pA0, pA1, NT - 1, true, false, false, false);
    { float sacc = pB0[0] + pB0[1];
#pragma unroll
      for (int r = 2; r < 16; ++r) sacc += pB0[r];
#pragma unroll
      for (int r = 0; r < 16; ++r) sacc += pB1[r];
      l_reg += sacc;
      pw0 = (v4u){PKW(pB0, 0), PKW(pB0, 2), PKW(pB0, 4), PKW(pB0, 6)}; pw1 = (v4u){PKW(pB0, 8), PKW(pB0, 10), PKW(pB0, 12), PKW(pB0, 14)};
      pw2 = (v4u){PKW(pB1, 0), PKW(pB1, 2), PKW(pB1, 4), PKW(pB1, 6)}; pw3 = (v4u){PKW(pB1, 8), PKW(pB1, 10), PKW(pB1, 12), PKW(pB1, 14)};
      SBAR();
      const lds_cptr vp_ = vp0 + vs_cur;
#pragma unroll
      for (int i = 0; i < 8; ++i) VRD(i);
      o[0] = MFMA32(PAF(0), VFR(0), o[0]); o[1] = MFMA32(PAF(0), VFR(4), o[1]); o[0] = MFMA32(PAF(1), VFR(1), o[0]); o[1] = MFMA32(PAF(1), VFR(5), o[1]);
      o[0] = MFMA32(PAF(2), VFR(2), o[0]); o[1] = MFMA32(PAF(2), VFR(6), o[1]); o[0] = MFMA32(PAF(3), VFR(3), o[0]); o[1] = MFMA32(PAF(3), VFR(7), o[1]); }
    l_reg = half_swap_add(l_reg);
    int ln = lane; asm volatile("" : "+v"(ln));
    const int r32e = ln & 31, hie = ln >> 5;
    LAS float* wsf = (LAS float*)((LAS unsigned char*)lds + LDS_WS) + wid * 64;
    if (hie == 0) wsf[r32e] = l_reg;
    asm volatile("s_waitcnt lgkmcnt(0)" ::: "memory");
    float rli[16];
#pragma unroll
    for (int r = 0; r < 16; ++r) rli[r] = __builtin_amdgcn_rcpf(wsf[crow(r, hie)]);
    { LAS float* stg = (LAS float*)((LAS unsigned char*)lds + LDS_OST) + wid * 1024;
      const size_t obase = (size_t)(rowbase + q0 + wid * 32) * 1024 + 512 + h * 64;
#pragma unroll
      for (int d0 = 0; d0 < 2; ++d0) {
#pragma unroll
          for (int r = 0; r < 16; ++r) stg[crow(r, hie) * 32 + r32e] = o[d0][r] * rli[r];
          asm volatile("s_waitcnt lgkmcnt(0)" ::: "memory");
#pragma unroll
          for (int i = 0; i < 4; ++i) { const int row = i * 8 + (ln >> 3), ch = ln & 7; const f32x4 v = *(const LAS f32x4*)(stg + row * 32 + ch * 4);
              const size_t off = obase + (size_t)row * 1024 + d0 * 32 + ch * 4;
              const unsigned long long z = *(const LAS unsigned long long*)((LAS unsigned char*)lds + LDS_SZ + wid * 4096 + row * 128 + (d0 * 32 + ch * 4) * 2); const unsigned zl = (unsigned)z, zh = (unsigned)(z >> 32);
              const unsigned long long w = (unsigned long long)pk2(v[0] * bflo(zl), v[1] * bfhi(zl)) | ((unsigned long long)pk2(v[2] * bflo(zh), v[3] * bfhi(zh)) << 32);
              *(unsigned long long*)(T.MIX + off) = w; }
          asm volatile("s_waitcnt lgkmcnt(0)" ::: "memory");
      } }
    asm volatile("s_waitcnt lgkmcnt(0)\n\ts_barrier" ::: "memory");
#undef DMA_K
#undef DMA_V
#undef ROT
#undef EX
#undef PKW
#undef PAF
#undef VFR
#undef VRD
#undef KRD
#undef GA3
#undef GAPB
#undef STEP
#undef ENDW
}
#undef SBAR
#undef PIN
#undef WAIT_BAR
}

namespace dil4 {
constexpr int SLOT = 8192, WAVE_LDS = 2 * SLOT;
constexpr int TBC = 208;
constexpr int TB_OFF = 132096, WSF_OFF = TB_OFF + 3 * 4 * TBC * 4;
__device__ __forceinline__ void glds16s(const void* sbase, unsigned voff, unsigned lds_base) {
    unsigned sv; asm volatile("s_mov_b32 %0, m0\n\ts_mov_b32 m0, %3\n\ts_nop 0\n\tglobal_load_lds_dwordx4 %1, %2\n\ts_mov_b32 m0, %0" : "=&s"(sv) : "v"(voff), "s"(sbase), "s"(lds_base) : "memory"); }
struct T4 { const bf16 *QA, *KA, *VA; bf16 *OP0, *OP1, *OP2; float* LP; const float* BT; };
__device__ __forceinline__ void build_tables(const float* BT, int h, LAS unsigned char* lds) {
    LAS float* tb = (LAS float*)(lds + TB_OFF);
    for (int e = threadIdx.x; e < 3 * 4 * 192; e += NWAVES * 64) { const int p = e / 768, c = (e / 192) & 3, i = e % 192, ix = 190 - i - c; tb[(p * 4 + c) * TBC + i] = ix >= 0 ? BT[p * (8 * 192) + h * 192 + ix] : -INFINITY; }
}

template <int DIL>
__device__ __forceinline__ void run_task2(int s, int a0, long rowbase, int h, const T4& T, LAS unsigned char* wl, unsigned wl0, const LAS float* tbl, f32x16 (&oA)[2], f32x16 (&oB)[2], float& lA, float& lB, int lane) {
    const int r32 = lane & 31, hi = lane >> 5;
    const bf16* const kb = T.KA + rowbase * 512 + h * 64; const bf16* const vb = T.VA + rowbase * 512 + h * 64;
    unsigned kof[4], vof[4];
#pragma unroll
    for (int i = 0; i < 4; ++i) { const int row = 8 * i + (lane >> 3), ch = (lane & 7) ^ ((row >> 1) & 7); kof[i] = (unsigned)(row * DIL) * 1024u + (unsigned)ch * 16u;
        const int pc = (lane & 7) ^ (((row >> 1) & 1) << 2); vof[i] = (unsigned)(row * DIL) * 1024u + (unsigned)pc * 16u; }
    const int k0 = a0 >= 128 ? 0 : (128 - a0) >> 5;
#define DMA_SUB(k) do { const long tok = (long)(a0 - 128 + 32 * (k)) * DIL + s; const bf16* kbj = kb + tok * 512; const bf16* vbj = vb + tok * 512; const unsigned dst = wl0 + ((k) & 1) * SLOT; \
        _Pragma("unroll") for (int i = 0; i < 4; ++i) glds16s(kbj, kof[i], (unsigned)__builtin_amdgcn_readfirstlane(dst + i * 1024)); \
        _Pragma("unroll") for (int i = 0; i < 4; ++i) glds16s(vbj, vof[i], (unsigned)__builtin_amdgcn_readfirstlane(dst + 4096 + i * 1024)); } while (0)
    { const bf16* qbs = T.QA + (rowbase + (long)a0 * DIL + s) * 512 + h * 64;
#pragma unroll
      for (int i = 0; i < 8; ++i) glds16s(qbs + (long)(8 * (i & ~1)) * DIL * 512, kof[i & 1], (unsigned)__builtin_amdgcn_readfirstlane(wl0 + SLOT + i * 1024)); }
    DMA_SUB(k0);
    asm volatile("s_waitcnt vmcnt(8)" ::: "memory");
    bf16x8 qa[4], qb[4];
    { const LAS unsigned char* qs = wl + SLOT + r32 * 128;
#pragma unroll
      for (int d0 = 0; d0 < 4; ++d0) { qa[d0] = *(const LAS bf16x8*)(qs + (((2 * d0 + hi) ^ ((r32 >> 1) & 7)) * 16)); qb[d0] = *(const LAS bf16x8*)(qs + 4096 + (((2 * d0 + hi) ^ ((r32 >> 1) & 7)) * 16)); } }
    asm volatile("s_waitcnt lgkmcnt(0)" ::: "memory");
    DMA_SUB(k0 + 1);
    oA[0] = f32x16{}; oA[1] = f32x16{}; oB[0] = f32x16{}; oB[1] = f32x16{}; lA = 0.f; lB = 0.f;
    const int kro = r32 * 128, ksw = (r32 >> 1) & 7;
    const int vq = (lane & 15) >> 2, vsw = (vq >> 1) & 1;
    const lds_cptr vp0 = (lds_cptr)wl + 4096 + (4 * hi + vq) * 128 + ((lane >> 4) & 1) * 32 + (lane & 3) * 8;
#define GRP(O, L, Q, j) do { \
        f32x16 pj; { const LAS f32x4* bp = (const LAS f32x4*)(tbl + 32 * (j)); const f32x4 b0 = bp[0], b1 = bp[2], b2 = bp[4], b3 = bp[6]; \
          pj = (f32x16){b0[0], b0[1], b0[2], b0[3], b1[0], b1[1], b1[2], b1[3], b2[0], b2[1], b2[2], b2[3], b3[0], b3[1], b3[2], b3[3]}; } \
        _Pragma("unroll") for (int d0 = 0; d0 < 4; ++d0) pj = MFMA32(kf[d0], Q[d0], pj); \
        float sm = 0.f; \
        _Pragma("unroll") for (int r = 0; r < 16; ++r) { pj[r] = __builtin_amdgcn_exp2f(pj[r]); sm += pj[r]; } \
        L += sm; \
        v4u pw0, pw1; \
        _Pragma("unroll") for (int jj = 0; jj < 4; ++jj) { pw0[jj] = pk2(pj[2 * jj], pj[2 * jj + 1]); pw1[jj] = pk2(pj[8 + 2 * jj], pj[8 + 2 * jj + 1]); } \
        _Pragma("unroll") for (int dh = 0; dh < 2; ++dh) { O[dh] = MFMA32(__builtin_bit_cast(bf16x8, pw0), vf[dh][0], O[dh]); O[dh] = MFMA32(__builtin_bit_cast(bf16x8, pw1), vf[dh][1], O[dh]); } } while (0)
#define COMPUTE2(k) do { if ((k) >= k0) { \
        if ((k) < 5) asm volatile("s_waitcnt vmcnt(8)" ::: "memory"); else asm volatile("s_waitcnt vmcnt(0)" ::: "memory"); \
        const LAS unsigned char* ks = wl + ((k) & 1) * SLOT; \
        bf16x8 kf[4], vf[2][2]; \
        _Pragma("unroll") for (int d0 = 0; d0 < 4; ++d0) kf[d0] = *(const LAS bf16x8*)(ks + kro + (((2 * d0 + hi) ^ ksw) * 16)); \
        { const lds_cptr vp = vp0 + ((k) & 1) * SLOT; \
          _Pragma("unroll") for (int dh = 0; dh < 2; ++dh) { const lds_cptr vd = vp + ((dh ^ vsw) * 64); const s16x4 l0 = vtr(vd), h0 = vtr(vd + 1024), l1 = vtr(vd + 2048), h1 = vtr(vd + 3072); \
              vf[dh][0] = (bf16x8){l0[0], l0[1], l0[2], l0[3], h0[0], h0[1], h0[2], h0[3]}; vf[dh][1] = (bf16x8){l1[0], l1[1], l1[2], l1[3], h1[0], h1[1], h1[2], h1[3]}; } } \
        if ((k) <= 4) GRP(oA, lA, qa, (k)); \
        if ((k) >= 1) GRP(oB, lB, qb, (k) - 1); \
        asm volatile("s_waitcnt lgkmcnt(0)" ::: "memory"); \
        if ((k) + 2 <= 5) DMA_SUB((k) + 2); } } while (0)
    COMPUTE2(0); COMPUTE2(1); COMPUTE2(2); COMPUTE2(3); COMPUTE2(4); COMPUTE2(5);
#undef COMPUTE2
#undef GRP
#undef DMA_SUB
    lA = half_swap_add(lA); lB = half_swap_add(lB);
}
template <int DIL, int P>
__device__ __forceinline__ void store_group(const f32x16 (&o)[2], float l, int s, int a0, long rowbase, int h, const T4& T, LAS float* stg, LAS float* wsf, int lane) {
    const int r32 = lane & 31, hi = lane >> 5;
    if (hi == 0) wsf[r32] = l;
    asm volatile("s_waitcnt lgkmcnt(0)" ::: "memory");
#pragma unroll
    for (int dh = 0; dh < 2; ++dh) {
#pragma unroll
        for (int r = 0; r < 16; ++r) stg[crow(r, hi) * 32 + r32] = o[dh][r];
        asm volatile("s_waitcnt lgkmcnt(0)" ::: "memory");
#pragma unroll
        for (int i = 0; i < 4; ++i) { const int row = i * 8 + (lane >> 3), ch = lane & 7; const f32x4 v = *(const LAS f32x4*)(stg + row * 32 + ch * 4);
            const size_t tok = (size_t)(rowbase + (long)(a0 + row) * DIL + s); const size_t off = tok * 512 + h * 64 + dh * 32 + ch * 4;
            bf16* OP = P == 0 ? T.OP0 : P == 1 ? T.OP1 : T.OP2;
            *(unsigned long long*)(OP + off) = (unsigned long long)pk2(v[0], v[1]) | ((unsigned long long)pk2(v[2], v[3]) << 32);
            if (dh == 0 && ch == 0) T.LP[((size_t)P * M + tok) * 8 + h] = wsf[row]; }
        asm volatile("s_waitcnt lgkmcnt(0)" ::: "memory");
    }
}
template <int DIL, int P>
__device__ __forceinline__ void task2(int bh, int s, int a0, const T4 T, LAS unsigned char* lds) {
    const int tid = threadIdx.x; int lane = tid & 63; asm volatile("" : "+v"(lane)); const int wid = __builtin_amdgcn_readfirstlane(tid >> 6);
    const int r32 = lane & 31, hi = lane >> 5;
    const int b = bh >> 3, h = bh & 7; const long rowbase = (long)b * SEQ;
    LAS unsigned char* wl = lds + wid * WAVE_LDS; const unsigned wl0 = (unsigned)(uintptr_t)(lds) + wid * WAVE_LDS;
    const int ub = r32 - 4 * hi, cpy = (31 - ub) & 3; const LAS float* tlane = (const LAS float*)(lds + TB_OFF) + (P * 4 + cpy) * TBC + (31 - ub - cpy);
    f32x16 oA[2], oB[2]; float lA, lB;
    run_task2<DIL>(s, a0, rowbase, h, T, wl, wl0, tlane, oA, oB, lA, lB, lane);
    LAS float* wsf = (LAS float*)(lds + WSF_OFF) + wid * 32;
    LAS float* stg = (LAS float*)wl;
    store_group<DIL, P>(oA, lA, s, a0, rowbase, h, T, stg, wsf, lane);
    store_group<DIL, P>(oB, lB, s, a0 + 32, rowbase, h, T, stg, wsf, lane);
}
}

namespace dil5 {
using dil4::TBC; using dil4::TB_OFF; using dil4::WSF_OFF; using dil4::glds16s; using dil4::T4;
constexpr int LK = 0, LV = 49152, LST = 98304, CNT_OFF = LDSCTL_OFF + 768;
__device__ __forceinline__ bool chunk_ready(const volatile LAS unsigned* cnt, int ck, unsigned target) { const unsigned v = (unsigned)__builtin_amdgcn_readfirstlane((int)cnt[ck]); return (int)(v - target) >= 0; }

template <int DIL, int P>
__device__ __forceinline__ void segment(int bh, int s, int a0, unsigned target, const T4 T, LAS unsigned char* lds) {
    const int tid = threadIdx.x; int lane = tid & 63; asm volatile("" : "+v"(lane)); const int wid = __builtin_amdgcn_readfirstlane(tid >> 6);
    const int r32 = lane & 31, hi = lane >> 5;
    const int b = bh >> 3, h = bh & 7; const long rowbase = (long)b * SEQ;
    const unsigned lds0 = (unsigned)(uintptr_t)lds;
    asm volatile("s_waitcnt lgkmcnt(0)\n\ts_barrier" ::: "memory");
    const int cmin = a0 == 0 ? 2 : 0;
    { const int lr = lane >> 3;
      const bf16* qb = T.QA + (rowbase + (long)(a0 + 32 * wid) * DIL + s) * 512 + h * 64;
      const unsigned q0 = (unsigned)(lr * DIL) * 1024u + (unsigned)((lane & 7) ^ (lr >> 1)) * 16u, q1 = (unsigned)((8 + lr) * DIL) * 1024u + (unsigned)((lane & 7) ^ (4 + (lr >> 1))) * 16u;
#pragma unroll
      for (int i = 0; i < 4; ++i) glds16s(qb + (long)(8 * (i & ~1)) * DIL * 512, (i & 1) ? q1 : q0, (unsigned)__builtin_amdgcn_readfirstlane(lds0 + LST + wid * 4096 + i * 1024));
      const unsigned kw = (unsigned)(lr * DIL) * 1024u + (unsigned)((lane & 7) ^ ((4 * (wid & 1) + (lr >> 1)) & 7)) * 16u;
      const unsigned vw = (unsigned)(lr * DIL) * 1024u + (unsigned)((lane & 7) ^ (((lr >> 1) & 1) << 2)) * 16u;
      const bf16* kb = T.KA + (rowbase + (long)(a0 - 128 + 8 * wid) * DIL + s) * 512 + h * 64; const bf16* vb = T.VA + (rowbase + (long)(a0 - 128 + 8 * wid) * DIL + s) * 512 + h * 64;
#pragma unroll
      for (int c = 0; c < 6; ++c) if (c >= cmin) {
          glds16s(kb + (long)(64 * c) * DIL * 512, kw, (unsigned)__builtin_amdgcn_readfirstlane(lds0 + LK + (64 * c + 8 * wid) * 128));
          glds16s(vb + (long)(64 * c) * DIL * 512, vw, (unsigned)__builtin_amdgcn_readfirstlane(lds0 + LV + (64 * c + 8 * wid) * 128)); } }
    if (cmin) asm volatile("s_waitcnt vmcnt(8)" ::: "memory"); else asm volatile("s_waitcnt vmcnt(12)" ::: "memory");
    bf16x8 qr[4];
    { const LAS unsigned char* qs = lds + LST + wid * 4096 + r32 * 128;
#pragma unroll
      for (int d0 = 0; d0 < 4; ++d0) qr[d0] = *(const LAS bf16x8*)(qs + (((2 * d0 + hi) ^ ((r32 >> 1) & 7)) * 16)); }
    f32x16 o[2]; o[0] = f32x16{}; o[1] = f32x16{}; float l = 0.f;
    const int ub = r32 - 4 * hi, cpy = (31 - ub) & 3;
    const LAS float* tlane = (const LAS float*)(lds + TB_OFF) + (P * 4 + cpy) * TBC + (31 - ub - cpy);
    const int ksw = (r32 >> 1) & 7;
    const LAS unsigned char* kl = lds + LK + r32 * 128;
    const int vq = (lane & 15) >> 2, vsw = (vq >> 1) & 1;
    const lds_cptr vl = (lds_cptr)lds + LV + (4 * hi + vq) * 128 + ((lane >> 4) & 1) * 32 + (lane & 3) * 8;
    volatile LAS unsigned* cnt = (volatile LAS unsigned*)(lds + CNT_OFF);
#define COMPUTE(jv) do { const int sub = wid + (jv);                   \
        f32x16 pj; { const LAS f32x4* bp = (const LAS f32x4*)(tlane + 32 * (jv)); const f32x4 b0 = bp[0], b1 = bp[2], b2 = bp[4], b3 = bp[6]; \
          pj = (f32x16){b0[0], b0[1], b0[2], b0[3], b1[0], b1[1], b1[2], b1[3], b2[0], b2[1], b2[2], b2[3], b3[0], b3[1], b3[2], b3[3]}; } \
        const LAS unsigned char* ks = kl + sub * 4096; \
        bf16x8 kf[4], vf[2][2]; \
        _Pragma("unroll") for (int d0 = 0; d0 < 4; ++d0) kf[d0] = *(const LAS bf16x8*)(ks + (((2 * d0 + hi) ^ ksw) * 16)); \
        { const lds_cptr vp = vl + sub * 4096; \
          _Pragma("unroll") for (int dh = 0; dh < 2; ++dh) { const lds_cptr vd = vp + ((dh ^ vsw) * 64); const s16x4 l0 = vtr(vd), h0 = vtr(vd + 1024), l1 = vtr(vd + 2048), h1 = vtr(vd + 3072); \
              vf[dh][0] = (bf16x8){l0[0], l0[1], l0[2], l0[3], h0[0], h0[1], h0[2], h0[3]}; vf[dh][1] = (bf16x8){l1[0], l1[1], l1[2], l1[3], h1[0], h1[1], h1[2], h1[3]}; } } \
        _Pragma("unroll") for (int d0 = 0; d0 < 4; ++d0) pj = MFMA32(kf[d0], qr[d0], pj); \
        float sm = 0.f; \
        _Pragma("unroll") for (int r = 0; r < 16; ++r) { pj[r] = __builtin_amdgcn_exp2f(pj[r]); sm += pj[r]; } \
        l += sm; \
        v4u pw0, pw1; \
        _Pragma("unroll") for (int jj = 0; jj < 4; ++jj) { pw0[jj] = pk2(pj[2 * jj], pj[2 * jj + 1]); pw1[jj] = pk2(pj[8 + 2 * jj], pj[8 + 2 * jj + 1]); } \
        _Pragma("unroll") for (int dh = 0; dh < 2; ++dh) { o[dh] = MFMA32(__builtin_bit_cast(bf16x8, pw0), vf[dh][0], o[dh]); o[dh] = MFMA32(__builtin_bit_cast(bf16x8, pw1), vf[dh][1], o[dh]); } } while (0)
    int jn = a0 == 0 ? (wid >= 4 ? 0 : 4 - wid) : 0;
#define CH(c, N) do { if ((c) >= cmin) asm volatile("s_waitcnt vmcnt(" #N ")" ::: "memory"); \
        if (lane == 0) __hip_atomic_fetch_add((LAS unsigned*)(lds + CNT_OFF) + (c), 1u, __ATOMIC_RELAXED, __HIP_MEMORY_SCOPE_WORKGROUP); \
        while (jn <= 4) { const int ck = (wid + jn) >> 1; if (ck > (c) || !chunk_ready(cnt, ck, target)) break; asm volatile("" ::: "memory"); COMPUTE(jn); ++jn; } } while (0)
    CH(0, 10); CH(1, 8); CH(2, 6); CH(3, 4); CH(4, 2); CH(5, 0);
#undef CH
#pragma unroll 1
    while (jn <= 4) { const int ck = (wid + jn) >> 1; while (!chunk_ready(cnt, ck, target)) __builtin_amdgcn_s_sleep(1); asm volatile("" ::: "memory"); COMPUTE(jn); ++jn; }
#undef COMPUTE
    l = half_swap_add(l);
    LAS float* wsf = (LAS float*)(lds + WSF_OFF) + wid * 32;
    LAS float* stg = (LAS float*)(lds + LST + wid * 4096);
    dil4::store_group<DIL, P>(o, l, s, a0 + 32 * wid, rowbase, h, T, stg, wsf, lane);
}
}

namespace dil6 {
using dil4::TBC; using dil4::TB_OFF; using dil4::WSF_OFF; using dil4::glds16s; using dil4::T4;
constexpr int NS = 7, LA = 5, PA = 2, CSLOT = 16384;
constexpr int STG_LO = NS * CSLOT, STG_HI = WSF_OFF + 1024, CNT_OFF = LDSCTL_OFF + 768;
static_assert(STG_LO + 4 * 4096 <= LDSCTL_OFF && STG_HI + 4 * 4096 <= LDS_BYTES, "LDS map");
#define VMW_CASE(i) case i: asm volatile("s_waitcnt vmcnt(" #i ")" ::: "memory"); break;
__device__ __forceinline__ void vm_wait_le(int n) {
    switch (n > 15 ? 15 : n) { VMW_CASE(0) VMW_CASE(1) VMW_CASE(2) VMW_CASE(3) VMW_CASE(4) VMW_CASE(5) VMW_CASE(6) VMW_CASE(7) VMW_CASE(8) VMW_CASE(9) VMW_CASE(10) VMW_CASE(11) VMW_CASE(12) VMW_CASE(13) VMW_CASE(14) VMW_CASE(15) } }
#undef VMW_CASE
__device__ __forceinline__ bool cnt_ge(const volatile LAS unsigned* p, unsigned target) { const unsigned v = (unsigned)__builtin_amdgcn_readfirstlane((int)*p); return (int)(v - target) >= 0; }

template <int DIL, int P>
__device__ __forceinline__ void run(int bh, int s0, int a0r, int& slot, unsigned& occ, const T4 T, LAS unsigned char* lds) {
    const int tid = threadIdx.x; int lane = tid & 63; asm volatile("" : "+v"(lane)); const int wid = __builtin_amdgcn_readfirstlane(tid >> 6);
    const int r32 = lane & 31, hi = lane >> 5, lr = lane >> 3;
    const int b = bh >> 3, h = bh & 7; const long rowbase = (long)b * SEQ;
    const unsigned lds0 = (unsigned)(uintptr_t)lds;
    const int stg_off = wid < 4 ? STG_LO + wid * 4096 : STG_HI + (wid - 4) * 4096;
    const unsigned q0 = (unsigned)(lr * DIL) * 1024u + (unsigned)((lane & 7) ^ (lr >> 1)) * 16u, q1 = (unsigned)((8 + lr) * DIL) * 1024u + (unsigned)((lane & 7) ^ (4 + (lr >> 1))) * 16u;
    const unsigned kw = (unsigned)(lr * DIL) * 1024u + (unsigned)((lane & 7) ^ ((4 * (wid & 1) + (lr >> 1)) & 7)) * 16u;
    const unsigned vw = (unsigned)(lr * DIL) * 1024u + (unsigned)((lane & 7) ^ (((lr >> 1) & 1) << 2)) * 16u;
    const bf16* const kbase = T.KA + rowbase * 512 + h * 64; const bf16* const vbase = T.VA + rowbase * 512 + h * 64; const bf16* const qbase = T.QA + rowbase * 512 + h * 64;
    const int g0 = (P == 2 || a0r == 0) ? 2 : 0;
    volatile LAS unsigned* const rdy = (volatile LAS unsigned*)(lds + CNT_OFF); volatile LAS unsigned* const dne = (volatile LAS unsigned*)(lds + CNT_OFF + 32);
    int D = 0, Dq = 0; unsigned long long hist = 0;
    int ls = slot; unsigned lo = occ;
#define CHUNK_TOK(g) (P == 2 ? (long)(64 * (((g) - 2) & 3) + 8 * wid) * 16 + (s0 + (((g) - 2) >> 2)) : (long)(a0r - 128 + 64 * (g) + 8 * wid) * DIL + s0)
#define ISSUE_CHUNK(g) do { while (!cnt_ge(dne + ls, 8u * lo)) __builtin_amdgcn_s_sleep(1); asm volatile("" ::: "memory"); \
        const long tok_ = CHUNK_TOK(g); const unsigned dst_ = (unsigned)__builtin_amdgcn_readfirstlane(lds0 + ls * CSLOT + wid * 1024); \
        glds16s(kbase + tok_ * 512, kw, dst_); glds16s(vbase + tok_ * 512, vw, dst_ + 8192); D += 2; if (++ls == NS) { ls = 0; ++lo; } } while (0)
#define ISSUE_Q(k) do { const long tok_ = P == 2 ? (long)(32 * wid) * 16 + (s0 + (k)) : (long)(a0r + 256 * (k) + 32 * wid) * DIL + s0; const bf16* qb_ = qbase + tok_ * 512; \
        _Pragma("unroll") for (int i_ = 0; i_ < 4; ++i_) glds16s(qb_ + (long)(8 * (i_ & ~1)) * DIL * 512, (i_ & 1) ? q1 : q0, (unsigned)__builtin_amdgcn_readfirstlane(lds0 + stg_off + i_ * 1024)); D += 4; Dq = D; } while (0)
    ISSUE_Q(0);
#pragma unroll 1
    for (int gl = g0; gl < g0 + LA; ++gl) { ISSUE_CHUNK(gl); hist = (hist << 8) | (unsigned)(D & 255); }
    bf16x8 qr[4], qn[4]; f32x16 o[2]; float l = 0.f;
    qr[0] = qr[1] = qr[2] = qr[3] = bf16x8{}; qn[0] = qn[1] = qn[2] = qn[3] = bf16x8{}; o[0] = f32x16{}; o[1] = f32x16{};
    const int ub = r32 - 4 * hi, cpy = (31 - ub) & 3;
    const LAS float* tlane = (const LAS float*)(lds + TB_OFF) + (P * 4 + cpy) * TBC + (31 - ub - cpy);
    const int ksw = (r32 >> 1) & 7;
    const int vq = (lane & 15) >> 2, vsw = (vq >> 1) & 1;
    const int klane = r32 * 128, vlane = 8192 + (4 * hi + vq) * 128 + ((lane >> 4) & 1) * 32 + (lane & 3) * 8;
#define COMPUTE(jv, par) do { \
        f32x16 pj; { const LAS f32x4* bp = (const LAS f32x4*)(tlane + 32 * (jv)); const f32x4 b0 = bp[0], b1 = bp[2], b2 = bp[4], b3 = bp[6]; \
          pj = (f32x16){b0[0], b0[1], b0[2], b0[3], b1[0], b1[1], b1[2], b1[3], b2[0], b2[1], b2[2], b2[3], b3[0], b3[1], b3[2], b3[3]}; } \
        const LAS unsigned char* ks = lds + slot * CSLOT + (par) * 4096 + klane; \
        bf16x8 kf[4], vf[2][2]; \
        _Pragma("unroll") for (int d0 = 0; d0 < 4; ++d0) kf[d0] = *(const LAS bf16x8*)(ks + (((2 * d0 + hi) ^ ksw) * 16)); \
        { const lds_cptr vp = (lds_cptr)lds + slot * CSLOT + (par) * 4096 + vlane; \
          _Pragma("unroll") for (int dh = 0; dh < 2; ++dh) { const lds_cptr vd = vp + ((dh ^ vsw) * 64); const s16x4 l0 = vtr(vd), h0 = vtr(vd + 1024), l1 = vtr(vd + 2048), h1 = vtr(vd + 3072); \
              vf[dh][0] = (bf16x8){l0[0], l0[1], l0[2], l0[3], h0[0], h0[1], h0[2], h0[3]}; vf[dh][1] = (bf16x8){l1[0], l1[1], l1[2], l1[3], h1[0], h1[1], h1[2], h1[3]}; } } \
        _Pragma("unroll") for (int d0 = 0; d0 < 4; ++d0) pj = MFMA32(kf[d0], qr[d0], pj); \
        float sm = 0.f; \
        _Pragma("unroll") for (int r = 0; r < 16; ++r) { pj[r] = __builtin_amdgcn_exp2f(pj[r]); sm += pj[r]; } \
        l += sm; \
        v4u pw0, pw1; \
        _Pragma("unroll") for (int jj = 0; jj < 4; ++jj) { pw0[jj] = pk2(pj[2 * jj], pj[2 * jj + 1]); pw1[jj] = pk2(pj[8 + 2 * jj], pj[8 + 2 * jj + 1]); } \
        _Pragma("unroll") for (int dh = 0; dh < 2; ++dh) { o[dh] = MFMA32(vf[dh][0], __builtin_bit_cast(bf16x8, pw0), o[dh]); o[dh] = MFMA32(vf[dh][1], __builtin_bit_cast(bf16x8, pw1), o[dh]); } } while (0)
#pragma unroll 1
    for (int g = g0; g < 18; ++g) {
        if (g + LA < 18) ISSUE_CHUNK(g + LA);
        hist = (hist << 8) | (unsigned)(D & 255);
        if (g + PA < 18) {
            vm_wait_le((D - (int)((hist >> (8 * (LA - PA))) & 255)) & 255);
            if (g == g0) {
#pragma unroll
                for (int t = 0; t < PA; ++t) { const int sp = slot + t >= NS ? slot + t - NS : slot + t; if (lane == 0) __hip_atomic_fetch_add((LAS unsigned*)(lds + CNT_OFF) + sp, 1u, __ATOMIC_RELAXED, __HIP_MEMORY_SCOPE_WORKGROUP); } }
            const int sp = slot + PA >= NS ? slot + PA - NS : slot + PA;
            if (lane == 0) __hip_atomic_fetch_add((LAS unsigned*)(lds + CNT_OFF) + sp, 1u, __ATOMIC_RELAXED, __HIP_MEMORY_SCOPE_WORKGROUP);
        }
        const int d = g - (wid >> 1);
        if (d >= 0 && d < 16 && (d & 3) != 3) {
            const int k = d >> 2, m = d & 3, c = g - 4 * k;
            const int jmin = (P == 2 || (a0r == 0 && k == 0)) ? (wid >= 4 ? 0 : 4 - wid) : 0;
            if (m == 0 || g == g0) {
                if (k == 0) {
                    vm_wait_le((D - Dq) & 255);
                    const LAS unsigned char* qs = lds + stg_off + r32 * 128;
#pragma unroll
                    for (int d0 = 0; d0 < 4; ++d0) qr[d0] = *(const LAS bf16x8*)(qs + (((2 * d0 + hi) ^ ((r32 >> 1) & 7)) * 16));
                    asm volatile("s_waitcnt lgkmcnt(0)" ::: "memory");
                } else {
#pragma unroll
                    for (int d0 = 0; d0 < 4; ++d0) qr[d0] = qn[d0];
                }
                o[0] = f32x16{}; o[1] = f32x16{}; l = 0.f;
                if (k < 3) ISSUE_Q(k + 1);
            }
            while (!cnt_ge(rdy + slot, 8u * (occ + 1u))) __builtin_amdgcn_s_sleep(1);
            asm volatile("" ::: "memory");
            const int j0 = 2 * c - wid, j1 = j0 + 1;
            if (j0 >= jmin && j0 >= 0 && j0 <= 4) COMPUTE(j0, 0);
            if (j1 >= jmin && j1 >= 0 && j1 <= 4) COMPUTE(j1, 1);
            if (m == 2) {
                if (k < 3) {
                    vm_wait_le((D - Dq) & 255);
                    const LAS unsigned char* qs = lds + stg_off + r32 * 128;
#pragma unroll
                    for (int d0 = 0; d0 < 4; ++d0) qn[d0] = *(const LAS bf16x8*)(qs + (((2 * d0 + hi) ^ ((r32 >> 1) & 7)) * 16));
                    asm volatile("s_waitcnt lgkmcnt(0)" ::: "memory");
                }
                l = half_swap_add(l);
                const int s_ = P == 2 ? s0 + k : s0, a_ = P == 2 ? 32 * wid : a0r + 256 * k + 32 * wid;
                { LAS unsigned char* const sw = lds + stg_off + r32 * 128 + ((hi ^ (r32 >> 4)) & 1) * 8; const int rsw = (r32 >> 1) & 7;
#pragma unroll
                  for (int dh = 0; dh < 2; ++dh)
#pragma unroll
                      for (int g4 = 0; g4 < 4; ++g4) *(LAS unsigned long long*)(sw + (((dh * 4 + g4) ^ rsw) * 16)) = (unsigned long long)pk2(o[dh][4 * g4], o[dh][4 * g4 + 1]) | ((unsigned long long)pk2(o[dh][4 * g4 + 2], o[dh][4 * g4 + 3]) << 32); }
                asm volatile("s_waitcnt lgkmcnt(0)" ::: "memory");
                bf16* const OPb = (P == 0 ? T.OP0 : P == 1 ? T.OP1 : T.OP2) + h * 64 + (lane & 7) * 8;
#pragma unroll
                for (int it = 0; it < 4; ++it) { const int row = 8 * it + (lane >> 3);
                    const v4u x = *(const LAS v4u*)(lds + stg_off + row * 128 + (((lane & 7) ^ ((row >> 1) & 7)) * 16));
                    const v4u y = it >= 2 ? (v4u){x[2], x[3], x[0], x[1]} : x;
                    const size_t tok = (size_t)(rowbase + (long)(a_ + row) * DIL + s_);
                    asm volatile("global_store_dwordx4 %0, %1, off\n\ts_nop 1" :: "v"(OPb + tok * 512), "v"(y) : "memory"); }
                { const size_t tok = (size_t)(rowbase + (long)(a_ + r32) * DIL + s_);
                  asm volatile("global_store_dword %0, %1, off" :: "v"(T.LP + ((size_t)P * M + tok) * 8 + h), "v"(l) : "memory"); }
                asm volatile("s_waitcnt lgkmcnt(0)" ::: "memory");
            }
        }
        asm volatile("s_waitcnt lgkmcnt(0)" ::: "memory");
        if (lane == 0) __hip_atomic_fetch_add((LAS unsigned*)(lds + CNT_OFF + 32) + slot, 1u, __ATOMIC_RELAXED, __HIP_MEMORY_SCOPE_WORKGROUP);
        if (++slot == NS) { slot = 0; ++occ; }
    }
#undef COMPUTE
#undef ISSUE_Q
#undef ISSUE_CHUNK
#undef CHUNK_TOK
}
}


namespace p2c {
constexpr int WSLOT = 32768, STG = 132096, GT = STG + 8 * 2048;
constexpr int GT_QN = 0, GT_QR = 64, GT_KN = 96;
struct T2 { const bf16 *CQ, *CKV, *WQ, *WKV; const float *SSQ, *GN, *CS; bf16 *QB, *KN, *VB; };
__device__ __forceinline__ void glds16s(const void* sbase, unsigned voff, unsigned lds_base) {
    unsigned sv; asm volatile("s_mov_b32 %0, m0\n\ts_mov_b32 m0, %3\n\ts_nop 0\n\tglobal_load_lds_dwordx4 %1, %2\n\ts_mov_b32 m0, %0" : "=&s"(sv) : "v"(voff), "s"(sbase), "s"(lds_base) : "memory"); }
struct Packed { unsigned w[8]; };
__device__ __forceinline__ void pack_tile(Packed& p, const f32x16& a) {
#pragma unroll
    for (int i = 0; i < 8; ++i) p.w[i] = pk2(a[2 * i], a[2 * i + 1]);
}
__device__ __forceinline__ void flush_tile(const Packed& p, LAS unsigned char* stg, bf16* dst0, int pitch, int lane) {
    const int r32 = lane & 31, hi = lane >> 5;
#pragma unroll
    for (int g = 0; g < 4; ++g) { const int c8 = 2 * g + hi;
        *(LAS unsigned long long*)(stg + r32 * 64 + (((c8 >> 1) ^ (r32 & 3)) * 16) + (c8 & 1) * 8) = (unsigned long long)p.w[2 * g] | ((unsigned long long)p.w[2 * g + 1] << 32); }
    asm volatile("s_waitcnt lgkmcnt(0)" ::: "memory");
#pragma unroll
    for (int i = 0; i < 2; ++i) { const int row = i * 16 + (lane >> 2), ch = lane & 3; const v4u v = *(const LAS v4u*)(stg + row * 64 + ((ch ^ (row & 3)) * 16));
        *(v4u*)(dst0 + (size_t)row * pitch + ch * 8) = v; }
    asm volatile("s_waitcnt lgkmcnt(0)" ::: "memory");
}
__device__ __forceinline__ void unit(int u, const T2 T, LAS unsigned char* lds) {
    int tid = threadIdx.x; asm volatile("" : "+v"(tid));
    const int lane = tid & 63; const int wid = __builtin_amdgcn_readfirstlane(tid >> 6);
    const int r32 = lane & 31, hi = lane >> 5, rg = wid & 3, jh = wid >> 2, h4 = wid & 3;
    const unsigned lds0 = (unsigned)(uintptr_t)lds;
    const size_t tok0 = (size_t)u * 128 + rg * 32, tok = tok0 + r32;
    const int rq0 = 2 * h4 + (lane >> 5), rk0 = 4 * h4 + (lane >> 4);
    const unsigned vq0 = (unsigned)rq0 * 512u + (unsigned)((lane & 31) ^ rq0) * 16u;
    const unsigned vk0 = (unsigned)rk0 * 256u + (unsigned)((lane & 15) ^ rk0) * 16u;
    const unsigned wbuf = lds0 + jh * 2 * WSLOT + h4 * 1024;
#define DMA_Q(s) do { unsigned dst_ = wbuf + ((s) & 1) * WSLOT; const bf16* wb_ = T.WQ + (size_t)(6 * jh + (s)) * 64 * 256; unsigned v_ = vq0; asm volatile("" : "+v"(v_)); \
        _Pragma("unroll 1") for (int i = 0; i < 8; ++i) { glds16s(wb_, v_, (unsigned)__builtin_amdgcn_readfirstlane(dst_)); wb_ += 2048; dst_ += 4096; v_ ^= 128u; } } while (0)
#define DMA_KV(s) do { unsigned dst_ = wbuf + ((s) & 1) * WSLOT; const bf16* wb_ = T.WKV + (size_t)(8 * jh + (s) - 6) * 64 * 128; unsigned v_ = vk0; asm volatile("" : "+v"(v_)); \
        _Pragma("unroll 1") for (int i = 0; i < 4; ++i) { glds16s(wb_, v_, (unsigned)__builtin_amdgcn_readfirstlane(dst_)); wb_ += 2048; dst_ += 4096; } } while (0)
    bf16x8 aq[16];
#pragma unroll
    for (int ks = 0; ks < 16; ++ks) aq[ks] = *(const bf16x8*)(T.CQ + tok * 256 + ks * 16 + hi * 8);
    float rq, rk;
    { const f32x4 s0 = *(const f32x4*)(T.SSQ + tok * 8), s1 = *(const f32x4*)(T.SSQ + tok * 8 + 4);
      rq = rsqrtf(((s0[0] + s0[1]) + (s0[2] + s0[3])) * (1.0f / 256.0f) + EPS); rk = rsqrtf((s1[0] + s1[1]) * (1.0f / 128.0f) + EPS); }
    f32x4 cc[2], sn[2];
#pragma unroll
    for (int g = 0; g < 2; ++g) { cc[g] = *(const f32x4*)(T.CS + tok * 32 + 8 * g + 4 * hi); sn[g] = *(const f32x4*)(T.CS + tok * 32 + 16 + 8 * g + 4 * hi); }
    LAS float* gt = (LAS float*)(lds + GT);
    __syncthreads();
    if (tid < 160) gt[tid] = T.GN[GN_QN + tid];
    asm volatile("s_waitcnt vmcnt(0)" ::: "memory");
    __syncthreads();
    DMA_Q(0); DMA_Q(1);
    LAS unsigned char* stg = lds + STG + wid * 2048;
    const LAS unsigned char* wring = lds + jh * 2 * WSLOT;
    Packed pk0, pk1; bf16 *pd0 = nullptr, *pd1 = nullptr;
#pragma unroll 1
    for (int s = 0; s < 6; ++s) {
        if (s + 1 < 6) asm volatile("s_waitcnt vmcnt(8)" ::: "memory"); else asm volatile("s_waitcnt vmcnt(0)" ::: "memory");
        __builtin_amdgcn_s_barrier(); asm volatile("" ::: "memory");
        if (s > 0) { flush_tile(pk0, stg, pd0, 768, lane); flush_tile(pk1, stg, pd1, 768, lane); }
        const LAS unsigned char* wt = wring + (s & 1) * WSLOT;
        int swz_ = r32 & 15, r32_ = r32; asm volatile("" : "+v"(swz_), "+v"(r32_));
        f32x16 acc0 = f32x16{}, acc1 = f32x16{};
#pragma unroll
        for (int ks = 0; ks < 16; ++ks) { const int co = (((2 * ks + hi) ^ swz_) * 16);
            const bf16x8 w0 = *(const LAS bf16x8*)(wt + r32_ * 512 + co), w1 = *(const LAS bf16x8*)(wt + (r32_ + 32) * 512 + co);
            acc0 = MFMA32(w0, aq[ks], acc0); acc1 = MFMA32(w1, aq[ks], acc1); if ((ks & 3) == 3) __builtin_amdgcn_sched_barrier(0); }
        asm volatile("s_waitcnt lgkmcnt(0)" ::: "memory");
        __builtin_amdgcn_s_barrier(); asm volatile("" ::: "memory");
        const int j = 6 * jh + s;
        if (j < 8) {
            float ss = 0.f;
#pragma unroll
            for (int r = 0; r < 16; ++r) ss += acc0[r] * acc0[r] + acc1[r] * acc1[r];
            ss = half_swap_add(ss) * (rq * rq); const float rs = rsqrtf(ss * (1.0f / 64.0f) + EPS) * (SCALE_B * rq);
#pragma unroll
            for (int g = 0; g < 4; ++g) { const f32x4 g0 = *(const LAS f32x4*)(gt + GT_QN + 8 * g + 4 * hi) * rs, g1 = *(const LAS f32x4*)(gt + GT_QN + 32 + 8 * g + 4 * hi) * rs;
#pragma unroll
                for (int e = 0; e < 4; ++e) { acc0[4 * g + e] *= g0[e]; acc1[4 * g + e] *= g1[e]; } }
            pack_tile(pk0, acc0); pack_tile(pk1, acc1); pd0 = T.QB + tok0 * 768 + j * 96; pd1 = pd0 + 32;
        } else {
#pragma unroll
            for (int nt = 0; nt < 2; ++nt) { f32x16& a = nt ? acc1 : acc0; float ss = 0.f;
#pragma unroll
                for (int r = 0; r < 16; ++r) ss += a[r] * a[r];
                ss = half_swap_add(ss) * (rq * rq); const float rs = rsqrtf(ss * (1.0f / 32.0f) + EPS) * rq;
#pragma unroll
                for (int g = 0; g < 2; ++g) { const f32x4 g1 = *(const LAS f32x4*)(gt + GT_QR + 8 * g + 4 * hi) * rs, g2 = *(const LAS f32x4*)(gt + GT_QR + 16 + 8 * g + 4 * hi) * rs;
#pragma unroll
                    for (int e = 0; e < 4; ++e) { const float t1 = a[4 * g + e] * g1[e], t2 = a[8 + 4 * g + e] * g2[e];
                        a[4 * g + e] = (t1 * cc[g][e] - t2 * sn[g][e]) * SCALE_B; a[8 + 4 * g + e] = (t1 * sn[g][e] + t2 * cc[g][e]) * SCALE_B; } }
                if (nt == 0) { pack_tile(pk0, a); pd0 = T.QB + tok0 * 768 + (2 * (j - 8)) * 96 + 64; } else { pack_tile(pk1, a); pd1 = T.QB + tok0 * 768 + (2 * (j - 8) + 1) * 96 + 64; } }
        }
        if (s + 2 < 6) DMA_Q(s + 2);
    }
    bf16x8 ak[8];
#pragma unroll
    for (int ks = 0; ks < 8; ++ks) ak[ks] = *(const bf16x8*)(T.CKV + tok * 128 + ks * 16 + hi * 8);
    asm volatile("s_waitcnt vmcnt(0)" ::: "memory");
    __builtin_amdgcn_s_barrier(); asm volatile("" ::: "memory");
    DMA_KV(6); DMA_KV(7);
#pragma unroll 1
    for (int s = 6; s < 14; ++s) {
        if (s + 1 < 14) asm volatile("s_waitcnt vmcnt(4)" ::: "memory"); else asm volatile("s_waitcnt vmcnt(0)" ::: "memory");
        __builtin_amdgcn_s_barrier(); asm volatile("" ::: "memory");
        if (s == 6) { flush_tile(pk0, stg, pd0, 768, lane); flush_tile(pk1, stg, pd1, 768, lane); } else { flush_tile(pk0, stg, pd0, 512, lane); flush_tile(pk1, stg, pd1, 512, lane); }
        const LAS unsigned char* wt = wring + (s & 1) * WSLOT;
        int swz_ = r32 & 15, r32_ = r32; asm volatile("" : "+v"(swz_), "+v"(r32_));
        f32x16 acc0 = f32x16{}, acc1 = f32x16{};
#pragma unroll
        for (int ks = 0; ks < 8; ++ks) { const int co = (((2 * ks + hi) ^ swz_) * 16);
            const bf16x8 w0 = *(const LAS bf16x8*)(wt + r32_ * 256 + co), w1 = *(const LAS bf16x8*)(wt + (r32_ + 32) * 256 + co);
            acc0 = MFMA32(w0, ak[ks], acc0); acc1 = MFMA32(w1, ak[ks], acc1); if ((ks & 3) == 3) __builtin_amdgcn_sched_barrier(0); }
        asm volatile("s_waitcnt lgkmcnt(0)" ::: "memory");
        __builtin_amdgcn_s_barrier(); asm volatile("" ::: "memory");
        const int hd = s - 6;
        if (jh == 0) {
            float ss = 0.f;
#pragma unroll
            for (int r = 0; r < 16; ++r) ss += acc0[r] * acc0[r] + acc1[r] * acc1[r];
            ss = half_swap_add(ss) * (rk * rk); const float rs = rsqrtf(ss * (1.0f / 64.0f) + EPS) * rk;
#pragma unroll
            for (int g = 0; g < 4; ++g) { const f32x4 g0 = *(const LAS f32x4*)(gt + GT_KN + 8 * g + 4 * hi) * rs, g1 = *(const LAS f32x4*)(gt + GT_KN + 32 + 8 * g + 4 * hi) * rs;
#pragma unroll
                for (int e = 0; e < 4; ++e) { acc0[4 * g + e] *= g0[e]; acc1[4 * g + e] *= g1[e]; } }
        } else {
#pragma unroll
            for (int r = 0; r < 16; ++r) { acc0[r] *= rk; acc1[r] *= rk; }
        }
        pack_tile(pk0, acc0); pack_tile(pk1, acc1); pd0 = (jh == 0 ? T.KN : T.VB) + tok0 * 512 + hd * 64; pd1 = pd0 + 32;
        if (s + 2 < 14) DMA_KV(s + 2);
    }
    flush_tile(pk0, stg, pd0, 512, lane); flush_tile(pk1, stg, pd1, 512, lane);
#undef DMA_Q
#undef DMA_KV
}
}

struct Args { const void* in[18]; float* out; unsigned char* ws; int ph_lo, ph_hi, li, pad; };
constexpr int PER_PHASE = 6;
#ifndef MK_N_LAUNCHES
#define MK_N_LAUNCHES 1
#endif
constexpr int N_LAUNCHES = MK_N_LAUNCHES;

__global__ void __launch_bounds__(NWAVES * 64, 2) hybrid_fwd(Args args) {
    extern __shared__ __attribute__((aligned(16))) unsigned char lds[];
    Frame F;
    F.lds = (LAS unsigned char*)lds;
    F.MISC = (volatile LAS unsigned*)(F.lds + MISC_OFF);
    F.tid = threadIdx.x; F.lane = F.tid & 63; F.wave = __builtin_amdgcn_readfirstlane(F.tid >> 6);
    F.G = gridDim.x; { const int bx = blockIdx.x; F.vcu = (F.G % 8 == 0) ? (bx % 8) * (F.G / 8) + bx / 8 : bx; }
    unsigned char* const ws = args.ws;
    F.ctl = (gu32*)(ws + WS_CTL);
#define INF(i) ((const float*)args.in[i])
#define WSB(off) ((bf16*)(ws + (off)))
#define WSF(off) ((float*)(ws + (off)))
    for (int u = F.tid; u < (LDS_BYTES - LDSCTL_OFF) / 4; u += NWAVES * 64) ((LAS unsigned*)(F.lds + LDSCTL_OFF))[u] = 0u;
    __syncthreads();
    XcdBarrier bar; bar.bar = (unsigned*)(F.ctl + CW_BAR); bar.x = 0; bar.st = nullptr;
    if (N_LAUNCHES != PER_PHASE) bar = xcd_barrier_post((unsigned*)(F.ctl + CW_BAR), F.MISC + 8);
#define GRID_BAR() do { if (N_LAUNCHES == PER_PHASE) { if (F.tid == 0) __hip_atomic_store(F.ctl + CW_TMO, 0xBADBA0u, RLX_AGENT); } else { xcd_barrier(bar); } } while (0)
    const int lo = args.ph_lo, hi_ = args.ph_hi;
#define IN(k) (lo <= (k) && (k) < hi_)
#define BOTH(k) (IN(k) && IN((k) + 1))

    if (IN(0)) {
        ProIn P{INF(0), INF(2), INF(3), INF(4), INF(7), INF(8), INF(9), INF(10), INF(15), (const int*)args.in[1], WSB(WS_WIN), WSB(WS_WUQ), WSB(WS_WUKV), WSB(WS_WOUT), WSB(WS_XN), WSF(WS_CS), WSF(WS_BT), INF(5), INF(6), INF(11), INF(12), INF(13), INF(14), WSF(WS_GN)};
        p0_prologue(F, P); if (BOTH(0)) GRID_BAR(); }

    if (IN(1)) {
        pg8::Gemm g{WSB(WS_XN), WSB(WS_WIN), M, NIN, DMODEL}; pg8::StaticOrder S; S.init(M, NIN, F.G, (int)blockIdx.x);
        EpiP1 E{ws};
        pg8::gemm_phase<EpiP1, pg8::StaticOrder, true, true>(F.lds + RING_OFF, g, S, E);
        if (BOTH(1)) GRID_BAR();
    }
    if (IN(2)) {
        const p2c::T2 T{WSB(WS_CQ), WSB(WS_CKV), WSB(WS_WUQ), WSB(WS_WUKV), WSF(WS_SSQ), WSF(WS_GN), WSF(WS_CS), WSB(WS_QB), WSB(WS_KN), WSB(WS_VB)};
        for (int u = F.vcu; u < M / 128; u += F.G) p2c::unit(u, T, F.lds);
        __syncthreads();
        if (BOTH(2)) GRID_BAR();
    }
    if (IN(3)) {
        {
            const MlaT T{WSB(WS_QB), WSB(WS_KN), WSB(WS_KR), WSB(WS_VB), WSB(WS_SZ), WSB(WS_MIX)};
            for (int uidx = F.vcu; uidx < 1024; uidx += F.G) {
                int bh, qb;
                if (F.G == 256) { const int r = uidx >> 8, x = F.vcu >> 5, i = F.vcu & 31, c16 = i & 15; bh = 8 * x + 2 * r + (i >> 4); qb = (r & 1) ? 15 - c16 : c16; }
                else { bh = uidx >> 4; qb = uidx & 15; }
                mla2::unit(bh >> 3, bh & 7, qb, T, (char*)lds);
            }
        }
        __syncthreads();
        {
            const dil4::T4 T4{WSB(WS_QA), WSB(WS_KA), WSB(WS_VA), WSB(WS_OP0), WSB(WS_OP1), WSB(WS_OP2), WSF(WS_LP), WSF(WS_BT)};
            const float* BT = WSF(WS_BT);
            const bool loc = (F.G == 256); const int x = F.vcu >> 5, i = F.vcu & 31;
            int cur_h = -1; int slot = 0; unsigned occ = 0;
            const int nrounds = loc ? 3 : (768 + F.G - 1) / F.G;
#pragma unroll 1
            for (int n = 0; n < nrounds; ++n) {
                int bh, rr;
                if (loc) { const int idx = n * 32 + i, bsel = idx / 12; rr = idx - 12 * bsel; bh = 8 * bsel + x; }
                else { const int u = n * F.G + F.vcu; bh = u / 12; rr = u % 12; if (u >= 768) bh = -1; }
                const int h_ = bh & 7;
                if (h_ != cur_h || !loc) { __syncthreads(); if (bh >= 0) dil4::build_tables(BT, h_, F.lds); __syncthreads(); cur_h = h_; }
                if (bh >= 0) { const int p_ = rr >> 2, q_ = rr & 3;
                    if (p_ == 0) dil6::run<1, 0>(bh, 0, 1024 * q_, slot, occ, T4, F.lds); else if (p_ == 1) dil6::run<4, 1>(bh, q_, 0, slot, occ, T4, F.lds); else dil6::run<16, 2>(bh, 4 * q_, 0, slot, occ, T4, F.lds); }
            }
        }
        if (BOTH(3)) GRID_BAR();
    }
    if (IN(4)) {
        const bf16 *OP0 = WSB(WS_OP0), *OP1 = WSB(WS_OP1), *OP2 = WSB(WS_OP2), *SZ = WSB(WS_SZ); bf16* MIX = WSB(WS_MIX); const float* LP = WSF(WS_LP);
        const int gt = F.vcu * (NWAVES * 64) + F.tid, NGT = F.G * NWAVES * 64;
        for (int e = gt; e < M * 64; e += NGT) { const int row = e >> 6, c8 = (e & 63) * 8, h = c8 >> 6;
            const size_t off = (size_t)row * 512 + c8;
            const v4u a = *(const v4u*)(OP0 + off), b2 = *(const v4u*)(OP1 + off), c = *(const v4u*)(OP2 + off), z = *(const v4u*)(SZ + (size_t)row * 1024 + c8);
            const float lt = LP[((size_t)0 * M + row) * 8 + h] + LP[((size_t)1 * M + row) * 8 + h] + LP[((size_t)2 * M + row) * 8 + h]; const float rl = 1.0f / lt;
            v4u o;
#pragma unroll
            for (int k = 0; k < 4; ++k) { const float lo_ = (bflo(a[k]) + bflo(b2[k]) + bflo(c[k])) * rl * bflo(z[k]), hi2 = (bfhi(a[k]) + bfhi(b2[k]) + bfhi(c[k])) * rl * bfhi(z[k]); o[k] = pk2(lo_, hi2); }
            *(v4u*)(MIX + (size_t)row * 1024 + c8) = o; }
        if (BOTH(4)) GRID_BAR();
    }
    if (IN(5)) {
        pg8::Gemm g{WSB(WS_MIX), WSB(WS_WOUT), M, DMODEL, DMODEL}; pg8::StaticOrder S; S.init(M, DMODEL, F.G, (int)blockIdx.x);
        EpiOut E{INF(0), args.out};
        pg8::gemm_phase<EpiOut, pg8::StaticOrder, true, true>(F.lds + RING_OFF, g, S, E);
    }
#undef IN
#undef BOTH
}

extern "C" void kernel_launch(void* const* d_in, const int* in_sizes, int n_in, void* d_out, int out_size, void* d_ws, size_t ws_size, hipStream_t stream) {
    static int grid = 0;
    if (grid == 0) {
        if (n_in != 16 || in_sizes[0] != M * DMODEL || out_size != M * DMODEL || ws_size < WS_END) { fprintf(stderr, "kernel_launch: unexpected shapes (n_in %d, in0 %d, out %d, ws %zu)\n", n_in, n_in > 0 ? in_sizes[0] : -1, out_size, ws_size); grid = -1; return; }
        int dev = 0, cus = 0, per_cu = 0;
        if (hipGetDevice(&dev) != hipSuccess || hipDeviceGetAttribute(&cus, hipDeviceAttributeMultiprocessorCount, dev) != hipSuccess) { grid = -1; return; }
        if (hipFuncSetAttribute((const void*)hybrid_fwd, hipFuncAttributeMaxDynamicSharedMemorySize, LDS_BYTES) != hipSuccess) { fprintf(stderr, "kernel_launch: hipFuncSetAttribute failed\n"); grid = -1; return; }
        if (hipOccupancyMaxActiveBlocksPerMultiprocessor(&per_cu, (const void*)hybrid_fwd, NWAVES * 64, LDS_BYTES) != hipSuccess || per_cu < 1) { fprintf(stderr, "kernel_launch: occupancy query says %d blocks per CU\n", per_cu); (void)hipGetLastError(); grid = -1; return; }
        grid = cus;
    }
    if (grid < 0) return;
    (void)hipMemsetAsync((char*)d_ws + WS_CTL, 0, CTL_ZERO_BYTES, stream);
    Args a{};
    for (int i = 0; i < 16; ++i) a.in[i] = d_in[i];
    a.out = (float*)d_out; a.ws = (unsigned char*)d_ws;
    for (int li = 0; li < N_LAUNCHES; ++li) {
        if (N_LAUNCHES == PER_PHASE) { a.ph_lo = li; a.ph_hi = li + 1; } else { a.ph_lo = 0; a.ph_hi = PER_PHASE; }
        a.li = li;
        hipLaunchKernelGGL(hybrid_fwd, dim3(grid), dim3(NWAVES * 64), LDS_BYTES, stream, a);
    }
}
```
